# Optimizing an MI355X kernel written in HIP

```python
import math
import jax, jax.numpy as jnp
from jax import lax
import numpy as np

D_MODEL = 1024
BATCH = 8
SEQ = 4096
DEPTH = 1

PLE_DIM = 256
D_RG = D_MODEL // 2
RG_BLOCKS = 8
RG_BLOCK = D_RG // RG_BLOCKS
CONV_WIDTH = 4
RG_C = 8.0
D_HG = D_MODEL // 2
HG_HEAD_DIM = 128
HG_HEADS = D_HG // HG_HEAD_DIM
HG_CHUNK = 64
D_MIX = D_RG + D_HG
D_IN = 2 * D_RG + 4 * D_HG
EPS = 1e-6

kernel_name = "hymba_style_rglru_hgrn2_block"


def rms_norm(x, w):
    xf = x.astype(jnp.float32)
    y = xf * lax.rsqrt(jnp.mean(xf * xf, axis=-1, keepdims=True) + EPS)
    return (y * w.astype(jnp.float32)).astype(x.dtype)


def causal_depthwise_conv(x, w, b):
    T = x.shape[1]
    xp = jnp.pad(x, ((0, 0), (CONV_WIDTH - 1, 0), (0, 0)))
    y = b
    for j in range(CONV_WIDTH):
        y = y + xp[:, j:j + T] * w[j]
    return y


def rg_lru(x, wa, ba, wx, bx, lam):
    B, T, _ = x.shape
    xf = x.astype(jnp.float32)
    xb = xf.reshape(B, T, RG_BLOCKS, RG_BLOCK)
    r = jax.nn.sigmoid(jnp.einsum('btgi,gij->btgj', xb, wa.astype(jnp.float32)).reshape(B, T, D_RG) + ba)
    i = jax.nn.sigmoid(jnp.einsum('btgi,gij->btgj', xb, wx.astype(jnp.float32)).reshape(B, T, D_RG) + bx)
    log_a = -RG_C * r * jax.nn.softplus(-lam.astype(jnp.float32))
    a = jnp.exp(log_a)
    mult = jnp.sqrt(-jnp.expm1(2.0 * log_a))
    mult = jnp.where(jnp.arange(T)[None, :, None] == 0, 1.0, mult)
    u = mult * (i * xf)

    def combine(left, right):
        a_l, b_l = left
        a_r, b_r = right
        return a_l * a_r, a_r * b_l + b_r

    _, h = lax.associative_scan(combine, (a, u), axis=1)
    return h.astype(x.dtype)


def gla_chunked(q, k, logf, v):
    B, T, H, K = q.shape
    V = v.shape[-1]
    C = HG_CHUNK
    N = T // C

    def chunks(t):
        return t.reshape(B, N, C, H, t.shape[-1]).transpose(0, 3, 1, 2, 4)

    q, k, logf, v = chunks(q), chunks(k), chunks(logf), chunks(v)
    b = jnp.cumsum(logf, axis=3)
    b_last = b[:, :, :, -1:, :]
    qe = q * jnp.exp(b)
    ke = k * jnp.exp(-b)
    scores = jnp.einsum('bhnck,bhnsk->bhncs', qe, ke)
    causal = jnp.tril(jnp.ones((C, C), dtype=bool))
    scores = jnp.where(causal, scores, 0.0)
    o_intra = jnp.einsum('bhncs,bhnsv->bhncv', scores, v)

    kd = k * jnp.exp(b_last - b)
    dS = jnp.einsum('bhnsk,bhnsv->bhnkv', kd, v)
    decay = jnp.exp(b_last[:, :, :, 0, :])

    def step(S, inp):
        d, ds = inp
        return d[..., None] * S + ds, S

    S0 = jnp.zeros((B, H, K, V), jnp.float32)
    _, S_prev = lax.scan(step, S0, (jnp.moveaxis(decay, 2, 0), jnp.moveaxis(dS, 2, 0)))
    o_inter = jnp.einsum('bhnck,nbhkv->bhncv', qe, S_prev)
    o = o_intra + o_inter
    return o.transpose(0, 2, 3, 1, 4).reshape(B, T, H, V)


def hgrn2_branch(q, fz, iv, g, lb, norm_w):
    B, T, _ = q.shape
    qf, fzf, ivf, gf = (t.astype(jnp.float32) for t in (q, fz, iv, g))
    lb = lb.astype(jnp.float32)
    f = lb + (1.0 - lb) * jax.nn.sigmoid(fzf)
    logf = jnp.log(f)
    k = (1.0 - lb) * jax.nn.sigmoid(-fzf)
    qs = jax.nn.silu(qf) * (HG_HEAD_DIM ** -0.5)
    heads = lambda t: t.reshape(B, T, HG_HEADS, HG_HEAD_DIM)
    o = gla_chunked(heads(qs), heads(k), heads(logf), heads(ivf))
    o = o * lax.rsqrt(jnp.mean(o * o, axis=-1, keepdims=True) + EPS) * norm_w.astype(jnp.float32)
    o = o.reshape(B, T, D_HG) * jax.nn.silu(gf)
    return o.astype(q.dtype)


def setup_inputs(seed: int = 0) -> dict:
    key = jax.random.key(seed)
    ks = jax.random.split(key, 20)
    f32 = jnp.float32
    nrm = lambda k, shape, scale: scale * jax.random.normal(k, shape, f32)
    u = jax.random.uniform(ks[10], (DEPTH, D_RG), f32, minval=0.9, maxval=0.999)
    s = u ** (1.0 / RG_C)
    rg_lambda = jnp.log(s) - jnp.log1p(-s)
    return {
        "x": jax.random.normal(ks[0], (BATCH, SEQ, D_MODEL), f32),
        "p": jax.random.normal(ks[1], (DEPTH, BATCH, SEQ, PLE_DIM), f32),
        "norm_mix_w": 1.0 + nrm(ks[2], (DEPTH, D_MODEL), 0.1),
        "w_in": nrm(ks[3], (DEPTH, D_MODEL, D_IN), D_MODEL ** -0.5),
        "conv_w": nrm(ks[4], (DEPTH, CONV_WIDTH, D_RG), CONV_WIDTH ** -0.5),
        "conv_b": nrm(ks[5], (DEPTH, D_RG), 0.01),
        "rg_wa": nrm(ks[6], (DEPTH, RG_BLOCKS, RG_BLOCK, RG_BLOCK), RG_BLOCK ** -0.5),
        "rg_ba": nrm(ks[7], (DEPTH, D_RG), 0.1),
        "rg_wx": nrm(ks[8], (DEPTH, RG_BLOCKS, RG_BLOCK, RG_BLOCK), RG_BLOCK ** -0.5),
        "rg_bx": nrm(ks[9], (DEPTH, D_RG), 0.1),
        "rg_lambda": rg_lambda,
        "hg_lb": nrm(ks[11], (DEPTH + 1, D_HG), 0.1),
        "hg_norm_w": 1.0 + nrm(ks[12], (DEPTH, HG_HEAD_DIM), 0.1),
        "w_out": nrm(ks[13], (DEPTH, D_MIX, D_MODEL), D_MIX ** -0.5),
        "ple_norm_w": 1.0 + nrm(ks[14], (DEPTH, D_MODEL), 0.1),
        "w_ple_gate": nrm(ks[15], (DEPTH, D_MODEL, D_MODEL), D_MODEL ** -0.5),
        "b_ple_gate": nrm(ks[16], (DEPTH, D_MODEL), 0.1),
        "w_ple_proj": nrm(ks[17], (DEPTH, PLE_DIM, D_MODEL), PLE_DIM ** -0.5),
        "final_norm_w": 1.0 + nrm(ks[18], (D_MODEL,), 0.1),
    }


def reference(x, p, norm_mix_w, w_in, conv_w, conv_b, rg_wa, rg_ba, rg_wx, rg_bx,
              rg_lambda, hg_lb, hg_norm_w, w_out, ple_norm_w, w_ple_gate, b_ple_gate,
              w_ple_proj, final_norm_w):
    lb_all = jnp.cumsum(jax.nn.softmax(hg_lb.astype(jnp.float32), axis=0), axis=0)
    split_at = [D_RG, 2 * D_RG, 2 * D_RG + D_HG, 2 * D_RG + 2 * D_HG, 2 * D_RG + 3 * D_HG]
    h = x
    for l in range(DEPTH):
        u = rms_norm(h, norm_mix_w[l])
        proj = u @ w_in[l]
        xa, ga, qb, fb, ib, gb = jnp.split(proj, split_at, axis=-1)
        xa = causal_depthwise_conv(xa, conv_w[l], conv_b[l])
        ya = rg_lru(xa, rg_wa[l], rg_ba[l], rg_wx[l], rg_bx[l], rg_lambda[l]) * jax.nn.silu(ga)
        yb = hgrn2_branch(qb, fb, ib, gb, lb_all[l], hg_norm_w[l])
        h = h + jnp.concatenate([ya, yb], axis=-1) @ w_out[l]
        gate = jax.nn.sigmoid(rms_norm(h, ple_norm_w[l]) @ w_ple_gate[l] + b_ple_gate[l])
        h = h + gate * (p[l] @ w_ple_proj[l])
    return rms_norm(h, final_norm_w)
```

```cpp
#include <hip/hip_runtime.h>
#include <hip/hip_cooperative_groups.h>
#include <cstdio>
namespace cg = cooperative_groups;

#ifndef N_LAUNCHES
#define N_LAUNCHES 1
#endif

#define REP_G1 1
#define REP_P0 1
#define REP_SYNC 0
#define REP_G2 1
#define REP_G3 1
#define REP_G4 1
#define REP_H 1
#define REP_R 1
#ifndef CONC_BF16
#define CONC_BF16 false
#endif
#ifndef CONC_H
#define CONC_H true
#endif
#ifndef CONC_GATE
#define CONC_GATE true
#endif
#define LAS __attribute__((address_space(3)))
#define DI __device__ __forceinline__
typedef unsigned short bf16_t;
typedef short bf16x8 __attribute__((ext_vector_type(8)));
typedef float f32x2 __attribute__((ext_vector_type(2)));
typedef float f32x4 __attribute__((ext_vector_type(4)));
typedef float f32x16 __attribute__((ext_vector_type(16)));
typedef unsigned u32x2 __attribute__((ext_vector_type(2)));
typedef unsigned u32x4 __attribute__((ext_vector_type(4)));
typedef __bf16 bf16v2 __attribute__((ext_vector_type(2)));

DI unsigned pk_bf16(float lo, float hi) { bf16v2 v; v.x = (__bf16)lo; v.y = (__bf16)hi; return __builtin_bit_cast(unsigned, v); }
DI float bf_lo(unsigned w) { return __uint_as_float(w << 16); }
DI float bf_hi(unsigned w) { return __uint_as_float(w & 0xffff0000u); }
DI float bf1(bf16_t h) { return __uint_as_float(((unsigned)h) << 16); }
DI bf16_t f2bf(float f) { return (bf16_t)(pk_bf16(f, 0.f) & 0xffffu); }
DI float rcpf_(float x) { return __builtin_amdgcn_rcpf(x); }
DI float sigmoidf_(float z) { return rcpf_(1.0f + __expf(-z)); }

constexpr int M_ = 32768, D_ = 1024, DIN_ = 3072, T_ = 4096, PLE_ = 256;
constexpr int NSEG = 8, SEGLEN = 512;
constexpr int RG_NSEG = 32, RG_SEGLEN = 128;
constexpr float EPS_ = 1e-6f;
constexpr int COL_XA = 0, COL_GA = 512, COL_QB = 1024, COL_FB = 1536, COL_IB = 2048, COL_GB = 2560;

constexpr size_t WS_RSS1 = 0;
constexpr size_t WS_RSS2 = WS_RSS1 + (size_t)M_ * 4;
constexpr size_t WS_WIN = WS_RSS2 + (size_t)M_ * 4;
constexpr size_t WS_WOUT = WS_WIN + (size_t)3072 * 1024 * 2;
constexpr size_t WS_WG = WS_WOUT + (size_t)1024 * 1024 * 2;
constexpr size_t WS_WP = WS_WG + (size_t)1024 * 1024 * 2;
constexpr size_t WS_WRG = WS_WP + (size_t)1024 * 256 * 2;
constexpr size_t WS_RGAGG = WS_WRG + (size_t)2 * 8 * 64 * 64 * 2;
constexpr size_t WS_DSEG = WS_RGAGG + (size_t)8 * 32 * 512 * 8;
constexpr size_t WS_SSEG = WS_DSEG + (size_t)256 * 128 * 4;
constexpr size_t WS_U = WS_SSEG + (size_t)256 * 16384 * 4;
constexpr size_t WS_PB = WS_U + (size_t)M_ * 1024 * 2;
constexpr size_t WS_PROJ = WS_PB + (size_t)M_ * 256 * 2;
constexpr size_t WS_Y = WS_PROJ + (size_t)M_ * 3072 * 2;
constexpr size_t WS_HB = WS_Y + (size_t)M_ * 1024 * 2;
constexpr size_t WS_PP = WS_HB + (size_t)M_ * 1024 * 2;
constexpr size_t WS_PG = WS_PP;
constexpr size_t WS_BAR = WS_PP + (size_t)M_ * 1024 * 2;
constexpr size_t WS_RSX = WS_BAR + 16384;
constexpr size_t WS_END = WS_RSX + (size_t)M_ * 4;

DI size_t pidx(size_t row, int col) { return ((size_t)(col >> 7) * M_ + row) * 128 + (size_t)(col & 127); }
constexpr int LDS_BYTES = 144384;
constexpr int LDS_BARW = 144368;

struct Args { const float* in[19]; float* out; unsigned char* ws; int ph_lo, ph_hi; };

namespace pg8 {
constexpr int BM = 256, BK = 64, HALF = 128, HTB = HALF * BK * 2, STAGE_BYTES = 8 * HTB, NXCD = 8, WGM = 8;
DI int lds_byte(int r, int c) { const int st = (r >> 4) * 2 + (c >> 5), rr = r & 15, cc = c & 31, ob = rr * 64 + cc * 2; return st * 1024 + (ob ^ (((ob >> 9) & 1) << 5)); }
DI void stage_rc(int b, int& R, int& C) { const int st = b / 1024, sb = b % 1024, swz = sb ^ (((sb >> 9) & 1) << 5); R = (st >> 1) * 16 + swz / 64; C = (st & 1) * 32 + (swz % 64) / 2; }
DI int perm32(int rho) { const int n = rho >> 4, i = rho & 15; return 8 * (i >> 2) + 4 * n + (i & 3); }
struct Unit { int pm, pn; };
struct Gemm { const bf16_t* A; const bf16_t* Bt; int M, N, K; };
struct StaticOrder {
    int nM, nN, nwg, G, c;
    DI void init(int M, int N, int G_, int c_) { nM = M / BM; nN = N / BM; nwg = nM * nN; G = G_; c = c_; }
    DI bool next(int i, Unit& u) const {
        const long L = (long)i * G + c; if (L >= nwg) return false;
        int wgid = (int)L; { const int q = nwg / NXCD, r = nwg % NXCD, xcd = wgid % NXCD, off = wgid / NXCD; wgid = (xcd < r ? xcd * (q + 1) : r * (q + 1) + (xcd - r) * q) + off; }
        const int nig = WGM * nN, gid = wgid / nig, fm = gid * WGM, gsz = (nM - fm) < WGM ? (nM - fm) : WGM;
        u.pm = fm + ((wgid % nig) % gsz); u.pn = (wgid % nig) / gsz; return true;
    }
};
template <bool BLK> struct EpiBf16 {
    static constexpr bool PERM = true, CONC = CONC_BF16;
    bf16_t* O; int ldc;
    DI void operator()(const f32x4 (&acc)[2][2][4][2], const Unit& u, int wr, int wc, int fr, int fq) const {
        const int row0 = u.pm * BM + wr * 64 + fr, col0 = u.pn * BM + wc * 32 + 8 * fq;
#pragma unroll
        for (int ai = 0; ai < 2; ++ai)
#pragma unroll
            for (int m = 0; m < 4; ++m) { const int row = row0 + ai * HALF + m * 16;
#pragma unroll
                for (int bj = 0; bj < 2; ++bj) { const f32x4 v0 = acc[ai][bj][m][0], v1 = acc[ai][bj][m][1];
                    u32x4 w; w.x = pk_bf16(v0[0], v0[1]); w.y = pk_bf16(v0[2], v0[3]); w.z = pk_bf16(v1[0], v1[1]); w.w = pk_bf16(v1[2], v1[3]);
                    bf16_t* dst = BLK ? O + pidx((size_t)row, col0 + bj * HALF) : O + (size_t)row * ldc + col0 + bj * HALF;
                    *(u32x4*)dst = w; } }
    }
};
struct EpiH {
    static constexpr bool PERM = true, CONC = CONC_H;
    const bf16_t* ub; const float* rinv; bf16_t* hb; float* rss;
    DI void operator()(const f32x4 (&acc)[2][2][4][2], const Unit& u, int wr, int wc, int fr, int fq) const {
        const int row0 = u.pm * BM + wr * 64 + fr, col0 = u.pn * BM + wc * 32 + 8 * fq;
#pragma unroll
        for (int ai = 0; ai < 2; ++ai) {
            u32x4 xw[4][2]; float ri[4];
#pragma unroll
            for (int m = 0; m < 4; ++m) { const int row = row0 + ai * HALF + m * 16; ri[m] = rinv[row];
#pragma unroll
                for (int bj = 0; bj < 2; ++bj) xw[m][bj] = __builtin_nontemporal_load((const u32x4*)(ub + (size_t)row * D_ + col0 + bj * HALF)); }
#pragma unroll
            for (int m = 0; m < 4; ++m) { const int row = row0 + ai * HALF + m * 16; float ss = 0.f; const float rv = ri[m];
#pragma unroll
                for (int bj = 0; bj < 2; ++bj) { const size_t off = (size_t)row * D_ + col0 + bj * HALF; const u32x4 q = xw[m][bj];
                    const f32x4 x0 = (f32x4){bf_lo(q.x), bf_hi(q.x), bf_lo(q.y), bf_hi(q.y)}, x1 = (f32x4){bf_lo(q.z), bf_hi(q.z), bf_lo(q.w), bf_hi(q.w)};
                    const f32x4 v0 = acc[ai][bj][m][0] + x0 * rv, v1 = acc[ai][bj][m][1] + x1 * rv;
                    u32x4 w; w.x = pk_bf16(v0[0], v0[1]); w.y = pk_bf16(v0[2], v0[3]); w.z = pk_bf16(v1[0], v1[1]); w.w = pk_bf16(v1[2], v1[3]);
                    *(u32x4*)(hb + off) = w;
                    ss += (v0[0] * v0[0] + v0[1] * v0[1]) + (v0[2] * v0[2] + v0[3] * v0[3]) + (v1[0] * v1[0] + v1[1] * v1[1]) + (v1[2] * v1[2] + v1[3] * v1[3]); }
                ss += __shfl_xor(ss, 16); ss += __shfl_xor(ss, 32);
                if (fq == 0) unsafeAtomicAdd(rss + row, ss); }
        }
    }
};
struct EpiGate {
    static constexpr bool PERM = true, CONC = CONC_GATE;
    bf16_t* gpo; const bf16_t* pp; const float* bg; const float* rss1;
    DI void operator()(const f32x4 (&acc)[2][2][4][2], const Unit& u, int wr, int wc, int fr, int fq) const {
        const int row0 = u.pm * BM + wr * 64 + fr, col0 = u.pn * BM + wc * 32 + 8 * fq;
        f32x4 bv[2][2];
#pragma unroll
        for (int bj = 0; bj < 2; ++bj) { bv[bj][0] = *(const f32x4*)(bg + col0 + bj * HALF) * (-1.44269504f); bv[bj][1] = *(const f32x4*)(bg + col0 + bj * HALF + 4) * (-1.44269504f); }
#pragma unroll
        for (int ai = 0; ai < 2; ++ai) {
            u32x4 pw[4][2]; float rs[4];
#pragma unroll
            for (int m = 0; m < 4; ++m) { const int row = row0 + ai * HALF + m * 16; rs[m] = rss1[row];
#pragma unroll
                for (int bj = 0; bj < 2; ++bj) pw[m][bj] = __builtin_nontemporal_load((const u32x4*)(pp + (size_t)row * D_ + col0 + bj * HALF)); }
#pragma unroll
            for (int m = 0; m < 4; ++m) { const int row = row0 + ai * HALF + m * 16;
                const float rl = rsqrtf(rs[m] * (1.0f / 1024.0f) + EPS_) * (-1.44269504f);
#pragma unroll
                for (int bj = 0; bj < 2; ++bj) { const size_t off = (size_t)row * D_ + col0 + bj * HALF; const u32x4 pq = pw[m][bj];
                    const f32x4 p0 = (f32x4){bf_lo(pq.x), bf_hi(pq.x), bf_lo(pq.y), bf_hi(pq.y)}, p1 = (f32x4){bf_lo(pq.z), bf_hi(pq.z), bf_lo(pq.w), bf_hi(pq.w)};
                    f32x4 z0 = acc[ai][bj][m][0] * rl + bv[bj][0], z1 = acc[ai][bj][m][1] * rl + bv[bj][1];
#pragma unroll
                    for (int j = 0; j < 4; ++j) { z0[j] = __builtin_amdgcn_exp2f(z0[j]); z1[j] = __builtin_amdgcn_exp2f(z1[j]); }
                    z0 = z0 + 1.0f; z1 = z1 + 1.0f;
#pragma unroll
                    for (int j = 0; j < 4; ++j) { z0[j] = rcpf_(z0[j]); z1[j] = rcpf_(z1[j]); }
                    const f32x4 v0 = z0 * p0, v1 = z1 * p1;
                    u32x4 w; w.x = pk_bf16(v0[0], v0[1]); w.y = pk_bf16(v0[2], v0[3]); w.z = pk_bf16(v1[0], v1[1]); w.w = pk_bf16(v1[2], v1[3]);
                    *(u32x4*)(gpo + off) = w; } }
        }
    }
};

template <class Epi, class Sched>
DI void gemm_phase(LAS unsigned char* lds, const Gemm g, const Sched& S, const Epi& E) {
    const int tid = threadIdx.x, wid = __builtin_amdgcn_readfirstlane(tid >> 6), lane = tid & 63, wr = wid >> 2, wc = wid & 3, fr = lane & 15, fq = lane >> 4;
    const int K = g.K, nt = K / BK;
    unsigned voffA[2], voffB[2];
#pragma unroll
    for (int i = 0; i < 2; ++i) { int R, C; stage_rc(tid * 16 + i * 8192, R, C); const int Rb = Epi::PERM ? ((R & ~31) + perm32(R & 31)) : R;
        voffA[i] = (unsigned)(R * K + C) * 2u; voffB[i] = (unsigned)(Rb * K + C) * 2u; }
    const size_t kstep = (size_t)(BK * 2);
    const size_t hstep = (size_t)HALF * K * 2;
    const size_t tstep = 2 * hstep;
    const unsigned ldsw = (unsigned)wid * 1024u;
    const int aoff = lds_byte(wr * 64 + fr, fq * 8), boff = lds_byte(wc * 32 + fr, fq * 8);
#define PG8_SA(b, h) (((b) * 2 + (h)) * HTB)
#define PG8_SB(b, h) ((4 + (b) * 2 + (h)) * HTB)
#define PG8_STAGE(bufoff, gbase, voff) do { _Pragma("unroll") for (int _i = 0; _i < 2; ++_i) \
        __builtin_amdgcn_global_load_lds((const unsigned*)((const char*)(gbase) + (voff)[_i]), (LAS unsigned*)(lds + (bufoff) + ldsw + _i * 8192), 16, 0, 0); } while (0)
#define PG8_LDA(dst, b, h) do { _Pragma("unroll") for (int m = 0; m < 4; ++m) _Pragma("unroll") for (int k = 0; k < 2; ++k) dst[m][k] = *(const LAS bf16x8*)(lds + PG8_SA(b, h) + aoff + m * 2048 + k * 1024); } while (0)
#define PG8_LDB(dst, b, h) do { _Pragma("unroll") for (int n = 0; n < 2; ++n) _Pragma("unroll") for (int k = 0; k < 2; ++k) dst[n][k] = *(const LAS bf16x8*)(lds + PG8_SB(b, h) + boff + n * 2048 + k * 1024); } while (0)
#define PG8_MMA(ai, bj, At, Bt) do { __builtin_amdgcn_s_setprio(1); _Pragma("unroll") for (int m = 0; m < 4; ++m) _Pragma("unroll") for (int n = 0; n < 2; ++n) _Pragma("unroll") for (int k = 0; k < 2; ++k) \
        acc[ai][bj][m][n] = __builtin_amdgcn_mfma_f32_16x16x32_bf16(Bt[n][k], At[m][k], acc[ai][bj][m][n], 0, 0, 0); __builtin_amdgcn_s_setprio(0); } while (0)
#define PG8_WAIT_V(n) asm volatile("s_waitcnt vmcnt(" #n ")" ::: "memory")
#define PG8_WAIT_L(n) asm volatile("s_waitcnt lgkmcnt(" #n ")" ::: "memory")
#define PG8_BAR __builtin_amdgcn_s_barrier()
#define PG8_SCHED __builtin_amdgcn_sched_barrier(0)
    Unit cur, nxt; int ui = 0;
    if (!S.next(0, cur)) return;
    f32x4 acc[2][2][4][2];
#pragma unroll
    for (int a = 0; a < 2; ++a)
#pragma unroll
        for (int b = 0; b < 2; ++b)
#pragma unroll
            for (int m = 0; m < 4; ++m)
#pragma unroll
                for (int n = 0; n < 2; ++n) acc[a][b][m][n] = (f32x4){0.f, 0.f, 0.f, 0.f};
    bf16x8 At[4][2], B0[2][2], B1[2][2];
    const char* cA = (const char*)g.A + (size_t)cur.pm * tstep; const char* cB = (const char*)g.Bt + (size_t)cur.pn * tstep;
    PG8_STAGE(PG8_SB(0, 0), cB, voffB); PG8_STAGE(PG8_SA(0, 0), cA, voffA); PG8_STAGE(PG8_SB(0, 1), cB + hstep, voffB); PG8_STAGE(PG8_SA(0, 1), cA + hstep, voffA);
    if (wr == 1) PG8_BAR;
    PG8_WAIT_V(4); PG8_BAR;
    PG8_STAGE(PG8_SB(1, 0), cB + kstep, voffB); PG8_STAGE(PG8_SA(1, 0), cA + kstep, voffA); PG8_STAGE(PG8_SB(1, 1), cB + hstep + kstep, voffB);
    PG8_WAIT_V(6); PG8_BAR;
    for (;;) {
        const bool has_next = S.next(ui + 1, nxt);
        const char* nA = has_next ? (const char*)g.A + (size_t)nxt.pm * tstep : cA; const char* nB = has_next ? (const char*)g.Bt + (size_t)nxt.pn * tstep : cB;
        for (int t = 0; t < nt; t += 2) {
            const bool last = (t == nt - 2);
            const char* a1 = cA + (size_t)(t + 1) * kstep;
            const char* a2 = last ? nA : cA + (size_t)(t + 2) * kstep; const char* b2 = last ? nB : cB + (size_t)(t + 2) * kstep;
            const char* a3 = a2 + kstep; const char* b3 = b2 + kstep;
            PG8_LDB(B0, 0, 0); PG8_SCHED; PG8_LDA(At, 0, 0); PG8_STAGE(PG8_SA(1, 1), a1 + hstep, voffA);
            PG8_WAIT_L(8); PG8_BAR; PG8_WAIT_L(0); PG8_MMA(0, 0, At, B0); PG8_BAR; PG8_SCHED;
            PG8_LDB(B1, 0, 1); PG8_STAGE(PG8_SB(0, 0), b2, voffB);
            PG8_BAR; PG8_WAIT_L(0); PG8_MMA(0, 1, At, B1); PG8_BAR;
            PG8_LDA(At, 0, 1); PG8_STAGE(PG8_SA(0, 0), a2, voffA);
            PG8_BAR; PG8_WAIT_L(0); PG8_MMA(1, 0, At, B0); PG8_BAR; PG8_SCHED;
            PG8_STAGE(PG8_SB(0, 1), b2 + hstep, voffB);
            PG8_WAIT_V(6); PG8_BAR; PG8_MMA(1, 1, At, B1); PG8_BAR;
            PG8_LDB(B0, 1, 0); PG8_SCHED; PG8_LDA(At, 1, 0); PG8_STAGE(PG8_SA(0, 1), a2 + hstep, voffA);
            PG8_WAIT_L(8); PG8_BAR; PG8_WAIT_L(0); PG8_MMA(0, 0, At, B0); PG8_BAR; PG8_SCHED;
            PG8_LDB(B1, 1, 1); PG8_STAGE(PG8_SB(1, 0), b3, voffB);
            PG8_BAR; PG8_WAIT_L(0); PG8_MMA(0, 1, At, B1); PG8_BAR;
            PG8_LDA(At, 1, 1); PG8_STAGE(PG8_SA(1, 0), a3, voffA);
            PG8_BAR; PG8_WAIT_L(0); PG8_MMA(1, 0, At, B0); PG8_BAR; PG8_SCHED;
            PG8_STAGE(PG8_SB(1, 1), b3 + hstep, voffB);
            PG8_WAIT_V(6); PG8_BAR; PG8_MMA(1, 1, At, B1); PG8_BAR;
        }
        if (Epi::CONC && wr == 0) PG8_BAR;
        E(acc, cur, wr, wc, fr, fq);
        if (Epi::CONC && wr == 1) PG8_BAR;
        if (!has_next) break;
#pragma unroll
        for (int a = 0; a < 2; ++a)
#pragma unroll
            for (int b = 0; b < 2; ++b)
#pragma unroll
                for (int m = 0; m < 4; ++m)
#pragma unroll
                    for (int n = 0; n < 2; ++n) acc[a][b][m][n] = (f32x4){0.f, 0.f, 0.f, 0.f};
        cur = nxt; cA = nA; cB = nB; ++ui;
    }
    PG8_WAIT_V(0);
    if (wr == 0) PG8_BAR;
    PG8_BAR;
#undef PG8_SA
#undef PG8_SB
#undef PG8_STAGE
#undef PG8_LDA
#undef PG8_LDB
#undef PG8_MMA
#undef PG8_WAIT_V
#undef PG8_WAIT_L
#undef PG8_BAR
#undef PG8_SCHED
}
}

DI void p0_prologue(const Args& a, LAS unsigned char* lds) {
    const int tid = threadIdx.x, lane = tid & 63, wave = __builtin_amdgcn_readfirstlane(tid >> 6);
    const int gtid = blockIdx.x * 512 + tid, gsz = gridDim.x * 512;
    const int gw = blockIdx.x * 8 + wave, nw = gridDim.x * 8;
    float* rss = (float*)(a.ws + WS_RSS1);
    for (int i = gtid; i < 2 * M_; i += gsz) rss[i] = 0.f;
    {
        LAS float* tile = (LAS float*)(lds + wave * 16640);
        for (int tix = gw; tix < 1344; tix += nw) {
            const float* W; const float* sc; bf16_t* O; int K, N, kt, nt;
            if (tix < 768) { W = a.in[3]; sc = a.in[2]; O = (bf16_t*)(a.ws + WS_WIN); K = 1024; N = 3072; kt = tix / 48; nt = tix % 48; }
            else if (tix < 1024) { const int t = tix - 768; W = a.in[13]; sc = nullptr; O = (bf16_t*)(a.ws + WS_WOUT); K = 1024; N = 1024; kt = t / 16; nt = t % 16; }
            else if (tix < 1280) { const int t = tix - 1024; W = a.in[15]; sc = a.in[14]; O = (bf16_t*)(a.ws + WS_WG); K = 1024; N = 1024; kt = t / 16; nt = t % 16; }
            else { const int t = tix - 1280; W = a.in[17]; sc = nullptr; O = (bf16_t*)(a.ws + WS_WP); K = 256; N = 1024; kt = t / 16; nt = t % 16; }
            const int r = lane >> 4, c4 = lane & 15;
            f32x4 v[16];
#pragma unroll
            for (int i = 0; i < 16; ++i) v[i] = *(const f32x4*)(W + (size_t)(kt * 64 + 4 * i + r) * N + nt * 64 + 4 * c4);
#pragma unroll
            for (int i = 0; i < 16; ++i) { const int kl = 4 * i + r; const float sv = sc ? sc[kt * 64 + kl] : 1.0f;
#pragma unroll
                for (int j = 0; j < 4; ++j) tile[kl * 65 + 4 * c4 + j] = v[i][j] * sv; }
#pragma unroll
            for (int it = 0; it < 8; ++it) { const int n = 8 * it + (lane >> 3), kq = lane & 7; float t8[8];
#pragma unroll
                for (int i = 0; i < 8; ++i) t8[i] = tile[(8 * kq + i) * 65 + n];
                u32x4 o; o.x = pk_bf16(t8[0], t8[1]); o.y = pk_bf16(t8[2], t8[3]); o.z = pk_bf16(t8[4], t8[5]); o.w = pk_bf16(t8[6], t8[7]);
                *(u32x4*)(O + (size_t)(nt * 64 + n) * K + kt * 64 + 8 * kq) = o; }
        }
    }
    {
        bf16_t* wrg = (bf16_t*)(a.ws + WS_WRG);
        for (int i = gtid; i < 65536; i += gsz) { const int mat = i >> 15, g = (i >> 12) & 7, j = (i >> 6) & 63, ii = i & 63;
            const float* src = mat ? a.in[8] : a.in[6]; wrg[i] = f2bf(src[(g * 64 + ii) * 64 + j]); }
    }
    {
        for (int row = 2 * gw; row < M_; row += 2 * nw) {
            const f32x4* xr = (const f32x4*)(a.in[0] + (size_t)row * D_);
            f32x4 v[8]; float ss0 = 0.f, ss1 = 0.f;
#pragma unroll
            for (int i = 0; i < 8; ++i) v[i] = __builtin_nontemporal_load(xr + lane + 64 * i);
#pragma unroll
            for (int i = 0; i < 4; ++i) { ss0 += (v[i][0] * v[i][0] + v[i][1] * v[i][1]) + (v[i][2] * v[i][2] + v[i][3] * v[i][3]); ss1 += (v[4 + i][0] * v[4 + i][0] + v[4 + i][1] * v[4 + i][1]) + (v[4 + i][2] * v[4 + i][2] + v[4 + i][3] * v[4 + i][3]); }
#pragma unroll
            for (int o = 1; o < 64; o <<= 1) { ss0 += __shfl_xor(ss0, o); ss1 += __shfl_xor(ss1, o); }
            const float r0 = rsqrtf(ss0 * (1.0f / 1024.0f) + EPS_), r1 = rsqrtf(ss1 * (1.0f / 1024.0f) + EPS_);
            if (lane == 0) { float* rsx = (float*)(a.ws + WS_RSX); rsx[row] = sqrtf(ss0 * (1.0f / 1024.0f) + EPS_); rsx[row + 1] = sqrtf(ss1 * (1.0f / 1024.0f) + EPS_); }
            u32x2* ur = (u32x2*)(a.ws + WS_U + (size_t)row * 2048);
#pragma unroll
            for (int i = 0; i < 8; ++i) { const float rr = (i < 4) ? r0 : r1; u32x2 o; o.x = pk_bf16(v[i][0] * rr, v[i][1] * rr); o.y = pk_bf16(v[i][2] * rr, v[i][3] * rr); ur[lane + 64 * i] = o; }
        }
    }
}

constexpr int HG_QE = 0, HG_KE = 17408, HG_KDT = 34816, HG_VT = 53248, HG_SB = 71680, HG_P = 106496, HG_OB = 115712, HG_TOT = 133120, HG_DEC = 137216, HG_PART = 137728;
#define MFMA32(a, b, c) __builtin_amdgcn_mfma_f32_32x32x16_bf16((a), (b), (c), 0, 0, 0)
#define MFMA16(a, b, c) __builtin_amdgcn_mfma_f32_16x16x32_bf16((a), (b), (c), 0, 0, 0)

template <bool PASS2>
DI void hgrn_item(const Args& a, LAS unsigned char* lds, int b, int h, int seg, int fuse_sid = -1) {
    const int tid = threadIdx.x, lane = tid & 63, w = __builtin_amdgcn_readfirstlane(tid >> 6);
    const int l31 = lane & 31, hh = lane >> 5, l15 = lane & 15, q4 = lane >> 4;
    const bf16_t* proj = (const bf16_t*)(a.ws + WS_PROJ);
    const int item = (b * 4 + h) * NSEG + seg;
    const int k0 = 2 * lane;
    const float* hglb = a.in[11];
    const float lb0 = rcpf_(1.0f + __expf(hglb[512 + 128 * h + k0] - hglb[128 * h + k0]));
    const float lb1 = rcpf_(1.0f + __expf(hglb[512 + 128 * h + k0 + 1] - hglb[128 * h + k0 + 1]));
    const int kt = w >> 1;
    f32x16 S[2];
#pragma unroll
    for (int i = 0; i < 2; ++i)
#pragma unroll
        for (int r = 0; r < 16; ++r) S[i][r] = 0.f;
    float* sseg = (float*)(a.ws + WS_SSEG); float* dseg = (float*)(a.ws + WS_DSEG);
    if (PASS2) {
        float En[32]; f32x4 Dn[4];
#define HG_CARRY_LOAD(sp_) do { const int it2_ = item - seg + (sp_); const float* E_ = sseg + (size_t)it2_ * 16384 + (size_t)w * 2048 + lane; const float* Dp_ = dseg + it2_ * 128 + 32 * kt + 4 * hh; \
            _Pragma("unroll") for (int g_ = 0; g_ < 4; ++g_) Dn[g_] = *(const f32x4*)(Dp_ + 8 * g_); \
            _Pragma("unroll") for (int q_ = 0; q_ < 32; ++q_) En[q_] = E_[q_ * 64]; } while (0)
        if (seg > 0) HG_CARRY_LOAD(0);
        for (int sp = 0; sp < seg; ++sp) {
            float Ec[32]; f32x4 Dc[4];
#pragma unroll
            for (int q = 0; q < 32; ++q) Ec[q] = En[q];
#pragma unroll
            for (int g = 0; g < 4; ++g) Dc[g] = Dn[g];
            if (sp + 1 < seg) HG_CARRY_LOAD(sp + 1);
#pragma unroll
            for (int g = 0; g < 4; ++g)
#pragma unroll
                for (int i = 0; i < 2; ++i)
#pragma unroll
                    for (int j = 0; j < 4; ++j) S[i][4 * g + j] = S[i][4 * g + j] * Dc[g][j] + Ec[i * 16 + 4 * g + j];
        }
#undef HG_CARRY_LOAD
    }
    float segtot0 = 0.f, segtot1 = 0.f;
    const size_t row0 = (size_t)b * T_ + (size_t)seg * SEGLEN;
    const bool rgdo = PASS2 && fuse_sid >= 0 && (fuse_sid & 31) != 0;
    const int rg_g = (fuse_sid >> 5) & 7;
    const size_t rg_row0 = (size_t)(fuse_sid >> 8) * T_ + (size_t)(fuse_sid & 31) * RG_SEGLEN;
    if (rgdo) {
        const int rb_ = fuse_sid >> 8, sseg = fuse_sid & 31; const f32x2* rgagg = (const f32x2*)(a.ws + WS_RGAGG);
        float hc[4];
#pragma unroll
        for (int tj = 0; tj < 4; ++tj) hc[tj] = 0.f;
        for (int sp0 = 0; sp0 < sseg; sp0 += 8) {
            f32x2 ag[8][4];
#pragma unroll
            for (int k = 0; k < 8; ++k)
#pragma unroll
                for (int tj = 0; tj < 4; ++tj) { const int sp = (sp0 + k < sseg) ? sp0 + k : sseg - 1; ag[k][tj] = rgagg[(size_t)(rb_ * RG_NSEG + sp) * 512 + 64 * rg_g + 16 * tj + l15]; }
#pragma unroll
            for (int k = 0; k < 8; ++k) { if (sp0 + k < sseg) {
#pragma unroll
                    for (int tj = 0; tj < 4; ++tj) hc[tj] = ag[k][tj].x * hc[tj] + ag[k][tj].y; } }
        }
        LAS float* const Xc = (LAS float*)(lds + 139264 + w * 256);
        if (q4 == 0) {
#pragma unroll
            for (int tj = 0; tj < 4; ++tj) Xc[16 * tj + l15] = hc[tj]; }
    }
    f32x4 nwv[4];
#pragma unroll
    for (int j = 0; j < 4; ++j) nwv[j] = *(const f32x4*)(a.in[12] + 8 * (tid & 7) + 64 * (j >> 1) + 4 * (j & 1));
    unsigned fzn[8], vn[8], qn[8];
#pragma unroll
    for (int i = 0; i < 8; ++i) { const size_t rr = row0 + 8 * w + i;
        fzn[i] = *(const unsigned*)(proj + pidx(rr, COL_FB + 128 * h) + k0); vn[i] = *(const unsigned*)(proj + pidx(rr, COL_IB + 128 * h) + k0); if (PASS2) qn[i] = *(const unsigned*)(proj + pidx(rr, COL_QB + 128 * h) + k0); }
    for (int c = 0; c < 8; ++c) {
        const size_t rb = row0 + 64 * c;
        unsigned fzw[8], vw[8], qw[8];
#pragma unroll
        for (int i = 0; i < 8; ++i) { fzw[i] = fzn[i]; vw[i] = vn[i]; if (PASS2) qw[i] = qn[i]; }
        if (c < 7) {
#pragma unroll
            for (int i = 0; i < 8; ++i) { const size_t rr = rb + 64 + 8 * w + i;
                fzn[i] = *(const unsigned*)(proj + pidx(rr, COL_FB + 128 * h) + k0); vn[i] = *(const unsigned*)(proj + pidx(rr, COL_IB + 128 * h) + k0); if (PASS2) qn[i] = *(const unsigned*)(proj + pidx(rr, COL_QB + 128 * h) + k0); } }
        u32x4 gpa, gpb;
        if (PASS2) { const bf16_t* gp = proj + pidx(rb + (tid >> 3), COL_GB + 128 * h) + 8 * (tid & 7); gpa = *(const u32x4*)gp; gpb = *(const u32x4*)(gp + 64); }
        float bl0[8], bl1[8], kk0[8], kk1[8]; float c0 = 0.f, c1 = 0.f;
#pragma unroll
        for (int i = 0; i < 8; ++i) {
            const float z0 = bf_lo(fzw[i]), z1 = bf_hi(fzw[i]);
            const float e0 = __expf(-z0), e1 = __expf(-z1);
            const float s0 = rcpf_(1.0f + e0), s1 = rcpf_(1.0f + e1);
            const float f0 = lb0 + (1.0f - lb0) * s0, f1 = lb1 + (1.0f - lb1) * s1;
            c0 += __logf(f0); c1 += __logf(f1); bl0[i] = c0; bl1[i] = c1;
            kk0[i] = (1.0f - lb0) * e0 * s0; kk1[i] = (1.0f - lb1) * e1 * s1;
        }
        *(LAS f32x2*)(lds + HG_TOT + (w * 128 + k0) * 4) = (f32x2){c0, c1};
        if (PASS2) {
#pragma unroll
            for (int i = 0; i < 2; ++i) { const int v = 32 * ((w & 1) * 2 + i) + l31;
#pragma unroll
                for (int g = 0; g < 4; ++g) { u32x2 o; o.x = pk_bf16(S[i][4 * g], S[i][4 * g + 1]); o.y = pk_bf16(S[i][4 * g + 2], S[i][4 * g + 3]);
                    *(LAS u32x2*)(lds + HG_SB + v * 272 + (32 * kt + 8 * g + 4 * hh) * 2) = o; } }
        }
        __syncthreads();
        float pre0 = 0.f, pre1 = 0.f, tot0 = 0.f, tot1 = 0.f;
#pragma unroll
        for (int g = 0; g < 8; ++g) { const f32x2 t = *(const LAS f32x2*)(lds + HG_TOT + (g * 128 + k0) * 4); if (g < w) { pre0 += t.x; pre1 += t.y; } tot0 += t.x; tot1 += t.y; }
        segtot0 += tot0; segtot1 += tot1;
        {
            float kd0[8], kd1[8];
#pragma unroll
            for (int i = 0; i < 8; ++i) {
                const float bb0 = pre0 + bl0[i], bb1 = pre1 + bl1[i];
                kd0[i] = kk0[i] * __expf(tot0 - bb0); kd1[i] = kk1[i] * __expf(tot1 - bb1);
                if (PASS2) {
                    const float eb0 = __expf(bb0), eb1 = __expf(bb1);
                    const float q0 = bf_lo(qw[i]), q1 = bf_hi(qw[i]);
                    const float qs0 = q0 * sigmoidf_(q0) * 0.08838834764831845f, qs1 = q1 * sigmoidf_(q1) * 0.08838834764831845f;
                    const int t = 8 * w + i;
                    *(LAS unsigned*)(lds + HG_QE + t * 272 + k0 * 2) = pk_bf16(qs0 * eb0, qs1 * eb1);
                    *(LAS unsigned*)(lds + HG_KE + t * 272 + k0 * 2) = pk_bf16(kk0[i] * rcpf_(eb0), kk1[i] * rcpf_(eb1));
                }
            }
            u32x4 o0, o1, p0, p1;
            o0.x = pk_bf16(kd0[0], kd0[1]); o0.y = pk_bf16(kd0[2], kd0[3]); o0.z = pk_bf16(kd0[4], kd0[5]); o0.w = pk_bf16(kd0[6], kd0[7]);
            o1.x = pk_bf16(kd1[0], kd1[1]); o1.y = pk_bf16(kd1[2], kd1[3]); o1.z = pk_bf16(kd1[4], kd1[5]); o1.w = pk_bf16(kd1[6], kd1[7]);
            p0.x = (vw[0] & 0xffffu) | (vw[1] << 16); p0.y = (vw[2] & 0xffffu) | (vw[3] << 16); p0.z = (vw[4] & 0xffffu) | (vw[5] << 16); p0.w = (vw[6] & 0xffffu) | (vw[7] << 16);
            p1.x = (vw[0] >> 16) | (vw[1] & 0xffff0000u); p1.y = (vw[2] >> 16) | (vw[3] & 0xffff0000u); p1.z = (vw[4] >> 16) | (vw[5] & 0xffff0000u); p1.w = (vw[6] >> 16) | (vw[7] & 0xffff0000u);
            *(LAS u32x4*)(lds + HG_KDT + k0 * 144 + 16 * w) = o0; *(LAS u32x4*)(lds + HG_KDT + (k0 + 1) * 144 + 16 * w) = o1;
            *(LAS u32x4*)(lds + HG_VT + k0 * 144 + 16 * w) = p0; *(LAS u32x4*)(lds + HG_VT + (k0 + 1) * 144 + 16 * w) = p1;
            if (w == 0) *(LAS f32x2*)(lds + HG_DEC + k0 * 4) = (f32x2){__expf(tot0), __expf(tot1)};
        }
        __syncthreads();
        u32x4 rgy0, rgy1, rgp0, rgp1;
        if (rgdo) { const size_t r = rg_row0 + 16 * c + (lane >> 2); const int c0 = 8 * (lane & 3);
            const bf16_t* yp = (const bf16_t*)(a.ws + WS_Y) + r * D_ + 64 * rg_g + c0; const bf16_t* pq = (const bf16_t*)(a.ws + WS_PG) + r * 512 + 64 * rg_g + c0;
            rgy0 = *(const u32x4*)yp; rgy1 = *(const u32x4*)(yp + 32); rgp0 = __builtin_nontemporal_load((const u32x4*)pq); rgp1 = __builtin_nontemporal_load((const u32x4*)(pq + 32)); }
        f32x16 o;
        const int vt = w >> 1, tt = w & 1;
        if (PASS2) {
            { const int ti = w >> 1;
#pragma unroll
              for (int jj = 0; jj < 2; ++jj) { const int tj = 2 * (w & 1) + jj; f32x4 sc = (f32x4){0.f, 0.f, 0.f, 0.f};
                if (tj <= ti) {
#pragma unroll
                    for (int st = 0; st < 4; ++st) { const bf16x8 fa = *(const LAS bf16x8*)(lds + HG_QE + (16 * ti + l15) * 272 + (32 * st + 8 * q4) * 2);
                        const bf16x8 fb = *(const LAS bf16x8*)(lds + HG_KE + (16 * tj + l15) * 272 + (32 * st + 8 * q4) * 2); sc = MFMA16(fa, fb, sc); } }
                const int s = 16 * tj + l15;
#pragma unroll
                for (int r = 0; r < 4; ++r) { const int t = 16 * ti + 4 * q4 + r; const float v = (tj <= ti && s <= t) ? sc[r] : 0.f;
                    *(LAS bf16_t*)(lds + HG_P + t * 144 + s * 2) = f2bf(v); } }
            }
            __syncthreads();
            f32x16 o2;
#pragma unroll
            for (int r = 0; r < 16; ++r) { o[r] = 0.f; o2[r] = 0.f; }
#pragma unroll
            for (int st = 0; st < 8; ++st) { const bf16x8 fa = *(const LAS bf16x8*)(lds + HG_SB + (32 * vt + l31) * 272 + (16 * st + 8 * hh) * 2);
                const bf16x8 fb = *(const LAS bf16x8*)(lds + HG_QE + (32 * tt + l31) * 272 + (16 * st + 8 * hh) * 2); if (st & 1) o2 = MFMA32(fa, fb, o2); else o = MFMA32(fa, fb, o); }
#pragma unroll
            for (int st = 0; st < 4; ++st) { const bf16x8 fa = *(const LAS bf16x8*)(lds + HG_VT + (32 * vt + l31) * 144 + (16 * st + 8 * hh) * 2);
                const bf16x8 fb = *(const LAS bf16x8*)(lds + HG_P + (32 * tt + l31) * 144 + (16 * st + 8 * hh) * 2); if (st & 1) o2 = MFMA32(fa, fb, o2); else o = MFMA32(fa, fb, o); }
            float ss = 0.f;
#pragma unroll
            for (int r = 0; r < 16; ++r) { o[r] += o2[r]; ss += o[r] * o[r]; }
            ss += __shfl_xor(ss, 32);
            if (hh == 0) *(LAS float*)(lds + HG_PART + (vt * 64 + 32 * tt + l31) * 4) = ss;
            { const int t = 32 * tt + l31;
#pragma unroll
              for (int g = 0; g < 4; ++g) { const int v0 = 32 * vt + 8 * g + 4 * hh; u32x2 ow; ow.x = pk_bf16(o[4 * g], o[4 * g + 1]); ow.y = pk_bf16(o[4 * g + 2], o[4 * g + 3]);
                  *(LAS u32x2*)(lds + HG_OB + t * 272 + v0 * 2) = ow; } }
        }
#pragma unroll
        for (int g = 0; g < 4; ++g) { const f32x4 d = *(const LAS f32x4*)(lds + HG_DEC + (32 * kt + 8 * g + 4 * hh) * 4);
#pragma unroll
            for (int i = 0; i < 2; ++i)
#pragma unroll
                for (int j = 0; j < 4; ++j) S[i][4 * g + j] *= d[j]; }
#pragma unroll
        for (int st = 0; st < 4; ++st) { const bf16x8 fa = *(const LAS bf16x8*)(lds + HG_KDT + (32 * kt + l31) * 144 + (16 * st + 8 * hh) * 2);
#pragma unroll
            for (int i = 0; i < 2; ++i) { const bf16x8 fb = *(const LAS bf16x8*)(lds + HG_VT + (32 * ((w & 1) * 2 + i) + l31) * 144 + (16 * st + 8 * hh) * 2); S[i] = MFMA32(fa, fb, S[i]); } }
        if (PASS2) {
            __syncthreads();
            { const int t = tid >> 3, v0 = 8 * (tid & 7);
              const float tot = (*(const LAS float*)(lds + HG_PART + t * 4) + *(const LAS float*)(lds + HG_PART + (64 + t) * 4)) + (*(const LAS float*)(lds + HG_PART + (128 + t) * 4) + *(const LAS float*)(lds + HG_PART + (192 + t) * 4));
              const float rstd = rsqrtf(tot * (1.0f / 128.0f) + EPS_);
              const u32x4 ga = gpa, gb = gpb;
              const u32x4 oa = *(const LAS u32x4*)(lds + HG_OB + t * 272 + v0 * 2), ob = *(const LAS u32x4*)(lds + HG_OB + t * 272 + (64 + v0) * 2);
              u32x4 ya, yb;
#pragma unroll
              for (int j = 0; j < 4; ++j) { float g0 = bf_lo(ga[j]), g1 = bf_hi(ga[j]); ya[j] = pk_bf16(bf_lo(oa[j]) * rstd * nwv[j >> 1][2 * (j & 1)] * g0 * sigmoidf_(g0), bf_hi(oa[j]) * rstd * nwv[j >> 1][2 * (j & 1) + 1] * g1 * sigmoidf_(g1));
                  g0 = bf_lo(gb[j]); g1 = bf_hi(gb[j]); yb[j] = pk_bf16(bf_lo(ob[j]) * rstd * nwv[2 + (j >> 1)][2 * (j & 1)] * g0 * sigmoidf_(g0), bf_hi(ob[j]) * rstd * nwv[2 + (j >> 1)][2 * (j & 1) + 1] * g1 * sigmoidf_(g1)); }
              bf16_t* yp = (bf16_t*)(a.ws + WS_Y) + (rb + t) * D_ + 512 + 128 * h + v0;
              *(u32x4*)yp = ya; *(u32x4*)(yp + 64) = yb; }
            if (rgdo) { const size_t r = rg_row0 + 16 * c + (lane >> 2); const int c0 = 8 * (lane & 3);
                bf16_t* yp = (bf16_t*)(a.ws + WS_Y) + r * D_ + 64 * rg_g + c0; u32x4 o0, o1;
                const LAS float* Xc = (const LAS float*)(lds + 139264 + w * 256); f32x4 rgc[4];
#pragma unroll
                for (int k = 0; k < 4; ++k) rgc[k] = *(const LAS f32x4*)(Xc + c0 + 32 * (k >> 1) + 4 * (k & 1));
#pragma unroll
                for (int j = 0; j < 4; ++j) { const f32x4 ca = rgc[j >> 1], cb2 = rgc[2 + (j >> 1)];
                    o0[j] = pk_bf16(bf_lo(rgy0[j]) + bf_lo(rgp0[j]) * ca[2 * (j & 1)], bf_hi(rgy0[j]) + bf_hi(rgp0[j]) * ca[2 * (j & 1) + 1]);
                    o1[j] = pk_bf16(bf_lo(rgy1[j]) + bf_lo(rgp1[j]) * cb2[2 * (j & 1)], bf_hi(rgy1[j]) + bf_hi(rgp1[j]) * cb2[2 * (j & 1) + 1]); }
                *(u32x4*)yp = o0; *(u32x4*)(yp + 32) = o1; }
        }
    }
    if (!PASS2) {
        float* E = sseg + (size_t)item * 16384 + (size_t)w * 2048 + lane;
#pragma unroll
        for (int i = 0; i < 2; ++i)
#pragma unroll
            for (int r = 0; r < 16; ++r) E[(i * 16 + r) * 64] = S[i][r];
        if (w == 0) *(f32x2*)(dseg + item * 128 + k0) = (f32x2){__expf(segtot0), __expf(segtot1)};
    }
    __syncthreads();
}


constexpr int H1_KDT = 0, H1_VT = 67584, H1_TOT = 135168, H1_SC = 139264, H1_DEC = 143360;
DI void hgrn_pass1(const Args& a, LAS unsigned char* lds, int b, int h, int seg) {
    const int tid = threadIdx.x, lane = tid & 63, w = __builtin_amdgcn_readfirstlane(tid >> 6);
    const int l31 = lane & 31, hh = lane >> 5;
    const bf16_t* proj = (const bf16_t*)(a.ws + WS_PROJ);
    const int item = (b * 4 + h) * NSEG + seg;
    const int k0 = 2 * lane;
    const float* hglb = a.in[11];
    const float lb0 = rcpf_(1.0f + __expf(hglb[512 + 128 * h + k0] - hglb[128 * h + k0]));
    const float lb1 = rcpf_(1.0f + __expf(hglb[512 + 128 * h + k0 + 1] - hglb[128 * h + k0 + 1]));
    const float om0 = 1.0f - lb0, om1 = 1.0f - lb1;
    const int kt = w >> 1;
    f32x16 S[2];
#pragma unroll
    for (int i = 0; i < 2; ++i)
#pragma unroll
        for (int r = 0; r < 16; ++r) S[i][r] = 0.f;
    float segtot0 = 0.f, segtot1 = 0.f;
    const size_t row0 = (size_t)b * T_ + (size_t)seg * SEGLEN;
    for (int half = 0; half < 2; ++half) {
        const size_t rb = row0 + 256 * half + 32 * w;
        float cum0 = 0.f, cum1 = 0.f;
#pragma unroll
        for (int j = 0; j < 4; ++j) {
            unsigned fzw[8], vw[8];
#pragma unroll
            for (int q = 0; q < 8; ++q) { const size_t rr = rb + 8 * j + q; fzw[q] = *(const unsigned*)(proj + pidx(rr, COL_FB + 128 * h) + k0); vw[q] = *(const unsigned*)(proj + pidx(rr, COL_IB + 128 * h) + k0); }
            float c0[8], c1[8];
#pragma unroll
            for (int q = 0; q < 8; ++q) {
                const float z0 = bf_lo(fzw[q]), z1 = bf_hi(fzw[q]);
                const float e0 = __expf(-z0), e1 = __expf(-z1);
                const float s0 = rcpf_(1.0f + e0), s1 = rcpf_(1.0f + e1);
                cum0 += __logf(lb0 + om0 * s0); cum1 += __logf(lb1 + om1 * s1);
                c0[q] = om0 * e0 * s0 * __expf(-cum0); c1[q] = om1 * e1 * s1 * __expf(-cum1); }
            u32x4 o0, o1, p0, p1;
#pragma unroll
            for (int q = 0; q < 4; ++q) { o0[q] = pk_bf16(c0[2 * q], c0[2 * q + 1]); o1[q] = pk_bf16(c1[2 * q], c1[2 * q + 1]);
                p0[q] = (vw[2 * q] & 0xffffu) | (vw[2 * q + 1] << 16); p1[q] = (vw[2 * q] >> 16) | (vw[2 * q + 1] & 0xffff0000u); }
            *(LAS u32x4*)(lds + H1_KDT + k0 * 528 + (32 * w + 8 * j) * 2) = o0; *(LAS u32x4*)(lds + H1_KDT + (k0 + 1) * 528 + (32 * w + 8 * j) * 2) = o1;
            *(LAS u32x4*)(lds + H1_VT + k0 * 528 + (32 * w + 8 * j) * 2) = p0; *(LAS u32x4*)(lds + H1_VT + (k0 + 1) * 528 + (32 * w + 8 * j) * 2) = p1;
        }
        *(LAS f32x2*)(lds + H1_TOT + (w * 128 + k0) * 4) = (f32x2){cum0, cum1};
        __syncthreads();
        {
            float suf0 = 0.f, suf1 = 0.f, tot0 = 0.f, tot1 = 0.f;
#pragma unroll
            for (int g = 0; g < 8; ++g) { const f32x2 t = *(const LAS f32x2*)(lds + H1_TOT + (g * 128 + k0) * 4); if (g >= w) { suf0 += t.x; suf1 += t.y; } tot0 += t.x; tot1 += t.y; }
            *(LAS f32x2*)(lds + H1_SC + (w * 128 + k0) * 4) = (f32x2){__expf(suf0), __expf(suf1)};
            segtot0 += tot0; segtot1 += tot1;
            if (w == 0) *(LAS f32x2*)(lds + H1_DEC + k0 * 4) = (f32x2){__expf(tot0), __expf(tot1)};
        }
        __syncthreads();
        if (half) {
#pragma unroll
            for (int q = 0; q < 4; ++q) { const f32x4 d = *(const LAS f32x4*)(lds + H1_DEC + (32 * kt + 8 * q + 4 * hh) * 4);
#pragma unroll
                for (int i = 0; i < 2; ++i)
#pragma unroll
                    for (int j = 0; j < 4; ++j) S[i][4 * q + j] *= d[j]; } }
#pragma unroll 2
        for (int g = 0; g < 8; ++g) {
            f32x16 part[2];
#pragma unroll
            for (int i = 0; i < 2; ++i)
#pragma unroll
                for (int r = 0; r < 16; ++r) part[i][r] = 0.f;
#pragma unroll
            for (int st = 0; st < 2; ++st) { const bf16x8 fa = *(const LAS bf16x8*)(lds + H1_KDT + (32 * kt + l31) * 528 + (32 * g + 16 * st + 8 * hh) * 2);
#pragma unroll
                for (int i = 0; i < 2; ++i) { const bf16x8 fb = *(const LAS bf16x8*)(lds + H1_VT + (32 * ((w & 1) * 2 + i) + l31) * 528 + (32 * g + 16 * st + 8 * hh) * 2); part[i] = MFMA32(fa, fb, part[i]); } }
#pragma unroll
            for (int q = 0; q < 4; ++q) { const f32x4 sv = *(const LAS f32x4*)(lds + H1_SC + (g * 128 + 32 * kt + 8 * q + 4 * hh) * 4);
#pragma unroll
                for (int i = 0; i < 2; ++i)
#pragma unroll
                    for (int j = 0; j < 4; ++j) S[i][4 * q + j] += sv[j] * part[i][4 * q + j]; }
        }
        __syncthreads();
    }
    float* E = (float*)(a.ws + WS_SSEG) + (size_t)item * 16384 + (size_t)w * 2048 + lane;
#pragma unroll
    for (int i = 0; i < 2; ++i)
#pragma unroll
        for (int r = 0; r < 16; ++r) E[(i * 16 + r) * 64] = S[i][r];
    if (w == 0) *(f32x2*)((float*)(a.ws + WS_DSEG) + item * 128 + k0) = (f32x2){__expf(segtot0), __expf(segtot1)};
}

constexpr int RG_WAVE_LDS = 4352;

DI void rg_pass1(const Args& a, LAS unsigned char* lds, int sid) {
    const int lane = threadIdx.x & 63, w = __builtin_amdgcn_readfirstlane((int)(threadIdx.x >> 6));
    const int l15 = lane & 15, q4 = lane >> 4;
    const int b = sid >> 8, g = (sid >> 5) & 7, sseg = sid & 31;
    LAS float* const X0 = (LAS float*)(lds + w * 4 * RG_WAVE_LDS);
    const bf16_t* proj = (const bf16_t*)(a.ws + WS_PROJ);
    const int chl = 64 * g + lane;
    const float cw0 = a.in[4][chl], cw1 = a.in[4][512 + chl], cw2 = a.in[4][1024 + chl], cw3 = a.in[4][1536 + chl], cb = a.in[5][chl];
    bf16x8 BwA[4][2], BwX[4][2]; float cba[4], cbx[4], ccr[4];
    const bf16_t* wrg = (const bf16_t*)(a.ws + WS_WRG);
#pragma unroll
    for (int tj = 0; tj < 4; ++tj) { const int j = 16 * tj + l15;
#pragma unroll
        for (int st = 0; st < 2; ++st) { BwA[tj][st] = *(const bf16x8*)(wrg + ((size_t)(0 * 8 + g) * 64 + j) * 64 + 32 * st + 8 * q4); BwX[tj][st] = *(const bf16x8*)(wrg + ((size_t)(1 * 8 + g) * 64 + j) * 64 + 32 * st + 8 * q4); }
        cba[tj] = a.in[7][64 * g + j]; cbx[tj] = a.in[9][64 * g + j];
        const float lam = a.in[10][64 * g + j];
        const float sp = (lam < -15.f) ? -lam : log1pf(__expf(-lam));
        ccr[tj] = -8.0f * sp; }
    f32x2* rgagg = (f32x2*)(a.ws + WS_RGAGG);
    float hc[4], prun[4];
#pragma unroll
    for (int tj = 0; tj < 4; ++tj) { hc[tj] = 0.f; prun[tj] = 1.f; }
    const size_t row0 = (size_t)b * T_ + (size_t)sseg * RG_SEGLEN;
    float h1 = 0.f, h2 = 0.f, h3 = 0.f;
    if (sseg > 0) { h3 = bf1(proj[pidx(row0 - 3, COL_XA + 64 * g) + lane]); h2 = bf1(proj[pidx(row0 - 2, COL_XA + 64 * g) + lane]); h1 = bf1(proj[pidx(row0 - 1, COL_XA + 64 * g) + lane]); }
    bf16_t xn[16];
#pragma unroll
    for (int i = 0; i < 16; ++i) xn[i] = proj[pidx(row0 + i, COL_XA + 64 * g) + lane];
#pragma unroll 2
    for (int tl = 0; tl < 8; ++tl) {
        const size_t rb = row0 + 16 * tl;
        LAS float* const X = X0 + (tl & 1) * (RG_WAVE_LDS / 4);
        LAS float* const XP = X0 + (2 + (tl & 1)) * (RG_WAVE_LDS / 4);
        float xa[16];
#pragma unroll
        for (int i = 0; i < 16; ++i) xa[i] = bf1(xn[i]);
        if (tl < 7) {
#pragma unroll
            for (int i = 0; i < 16; ++i) xn[i] = proj[pidx(rb + 16 + i, COL_XA + 64 * g) + lane]; }
        f32x4 pcv0, pcv1;
        { const f32x4* p4 = (const f32x4*)a.in[1] + (size_t)sid * 1024 + tl * 128 + lane; pcv0 = __builtin_nontemporal_load(p4); pcv1 = __builtin_nontemporal_load(p4 + 64); }
        u32x4 gw0, gw1;
        { const bf16_t* gp = proj + pidx(rb + (lane >> 2), COL_GA + 64 * g) + 8 * (lane & 3); gw0 = *(const u32x4*)gp; gw1 = *(const u32x4*)(gp + 32); }
#pragma unroll
        for (int i = 0; i < 16; ++i) { const float x3 = (i >= 3) ? xa[i - 3] : (i == 2 ? h1 : (i == 1 ? h2 : h3)), x2 = (i >= 2) ? xa[i - 2] : (i == 1 ? h1 : h2), x1 = (i >= 1) ? xa[i - 1] : h1;
            X[i * 68 + lane] = cb + (cw0 * x3 + cw1 * x2) + (cw2 * x1 + cw3 * xa[i]); }
        h3 = xa[13]; h2 = xa[14]; h1 = xa[15];
        bf16x8 fa[2];
#pragma unroll
        for (int st = 0; st < 2; ++st) { const f32x4 lo = *(const LAS f32x4*)(X + l15 * 68 + 32 * st + 8 * q4), hi = *(const LAS f32x4*)(X + l15 * 68 + 32 * st + 8 * q4 + 4);
            u32x4 p; p.x = pk_bf16(lo[0], lo[1]); p.y = pk_bf16(lo[2], lo[3]); p.z = pk_bf16(hi[0], hi[1]); p.w = pk_bf16(hi[2], hi[3]); fa[st] = __builtin_bit_cast(bf16x8, p); }
        float hl[4][4], pc[4][4], pinc[4], hinc[4];
#pragma unroll
        for (int tj = 0; tj < 4; ++tj) {
            f32x4 ar = (f32x4){0.f, 0.f, 0.f, 0.f}, ax = (f32x4){0.f, 0.f, 0.f, 0.f};
            ar = MFMA16(fa[0], BwA[tj][0], ar); ar = MFMA16(fa[1], BwA[tj][1], ar); ax = MFMA16(fa[0], BwX[tj][0], ax); ax = MFMA16(fa[1], BwX[tj][1], ax);
            float hh = 0.f, pp = 1.f;
#pragma unroll
            for (int r = 0; r < 4; ++r) { const int t = 4 * q4 + r;
                const float rr = sigmoidf_(ar[r] + cba[tj]), ii = sigmoidf_(ax[r] + cbx[tj]);
                const float la = ccr[tj] * rr; const float av = __expf(la);
                const float x2 = 2.0f * la;
                const float em = (x2 > -0.35f) ? x2 * (1.0f + x2 * 0.5f * (1.0f + x2 * (1.0f / 3.0f) * (1.0f + x2 * 0.25f * (1.0f + x2 * 0.2f * (1.0f + x2 * (1.0f / 6.0f)))))) : (__expf(x2) - 1.0f);
                float mult = __builtin_amdgcn_sqrtf(-em);
                if (sseg == 0 && tl == 0 && t == 0) mult = 1.0f;
                const float uv = mult * ii * X[t * 68 + 16 * tj + l15];
                hh = av * hh + uv; pp *= av; hl[tj][r] = hh; pc[tj][r] = pp; }
            float pu = __shfl_up(pp, 16), hu = __shfl_up(hh, 16);
            if (q4 >= 1) { hh = pp * hu + hh; pp = pp * pu; }
            pu = __shfl_up(pp, 32); hu = __shfl_up(hh, 32);
            if (q4 >= 2) { hh = pp * hu + hh; pp = pp * pu; }
            pinc[tj] = pp; hinc[tj] = hh;
        }
#pragma unroll
        for (int tj = 0; tj < 4; ++tj) { float pe = __shfl_up(pinc[tj], 16), he = __shfl_up(hinc[tj], 16); if (q4 == 0) { pe = 1.f; he = 0.f; }
            const float hin = pe * hc[tj] + he, pin = pe * prun[tj];
#pragma unroll
            for (int r = 0; r < 4; ++r) { X[(4 * q4 + r) * 68 + 16 * tj + l15] = hl[tj][r] + pc[tj][r] * hin; XP[(4 * q4 + r) * 68 + 16 * tj + l15] = pc[tj][r] * pin; } }
#pragma unroll
        for (int tj = 0; tj < 4; ++tj) { const float pt = __shfl(pinc[tj], 48 + l15), ht = __shfl(hinc[tj], 48 + l15); hc[tj] = pt * hc[tj] + ht; prun[tj] *= pt; }
        {
            const int t = lane >> 2, c0 = 8 * (lane & 3);
            f32x4 hv[4], pv[4];
#pragma unroll
            for (int k = 0; k < 4; ++k) { hv[k] = *(const LAS f32x4*)(X + t * 68 + c0 + 32 * (k >> 1) + 4 * (k & 1)); pv[k] = *(const LAS f32x4*)(XP + t * 68 + c0 + 32 * (k >> 1) + 4 * (k & 1)); }
            u32x4 y0, y1, p0, p1;
#pragma unroll
            for (int k = 0; k < 2; ++k) {
                float g0 = bf_lo(gw0[2 * k]), g1 = bf_hi(gw0[2 * k]), g2 = bf_lo(gw0[2 * k + 1]), g3 = bf_hi(gw0[2 * k + 1]);
                g0 *= sigmoidf_(g0); g1 *= sigmoidf_(g1); g2 *= sigmoidf_(g2); g3 *= sigmoidf_(g3);
                y0[2 * k] = pk_bf16(hv[k][0] * g0, hv[k][1] * g1); y0[2 * k + 1] = pk_bf16(hv[k][2] * g2, hv[k][3] * g3);
                p0[2 * k] = pk_bf16(pv[k][0] * g0, pv[k][1] * g1); p0[2 * k + 1] = pk_bf16(pv[k][2] * g2, pv[k][3] * g3);
                g0 = bf_lo(gw1[2 * k]); g1 = bf_hi(gw1[2 * k]); g2 = bf_lo(gw1[2 * k + 1]); g3 = bf_hi(gw1[2 * k + 1]);
                g0 *= sigmoidf_(g0); g1 *= sigmoidf_(g1); g2 *= sigmoidf_(g2); g3 *= sigmoidf_(g3);
                y1[2 * k] = pk_bf16(hv[2 + k][0] * g0, hv[2 + k][1] * g1); y1[2 * k + 1] = pk_bf16(hv[2 + k][2] * g2, hv[2 + k][3] * g3);
                p1[2 * k] = pk_bf16(pv[2 + k][0] * g0, pv[2 + k][1] * g1); p1[2 * k + 1] = pk_bf16(pv[2 + k][2] * g2, pv[2 + k][3] * g3); }
            bf16_t* yp = (bf16_t*)(a.ws + WS_Y) + (rb + t) * D_ + 64 * g + c0;
            *(u32x4*)yp = y0; *(u32x4*)(yp + 32) = y1;
            bf16_t* pq = (bf16_t*)(a.ws + WS_PG) + (rb + t) * 512 + 64 * g + c0;
            *(u32x4*)pq = p0; *(u32x4*)(pq + 32) = p1;
            { u32x2* pb = (u32x2*)(a.ws + WS_PB) + (size_t)sid * 1024 + tl * 128 + lane; u32x2 o; o.x = pk_bf16(pcv0[0], pcv0[1]); o.y = pk_bf16(pcv0[2], pcv0[3]); pb[0] = o; o.x = pk_bf16(pcv1[0], pcv1[1]); o.y = pk_bf16(pcv1[2], pcv1[3]); pb[64] = o; }
        }
    }
    if (q4 == 0) {
#pragma unroll
        for (int tj = 0; tj < 4; ++tj) rgagg[(size_t)(b * RG_NSEG + sseg) * 512 + 64 * g + 16 * tj + l15] = (f32x2){prun[tj], hc[tj]}; }
}

DI void rg_pass2(const Args& a, LAS unsigned char* lds, int sid) {
    const int lane = threadIdx.x & 63, w = __builtin_amdgcn_readfirstlane((int)(threadIdx.x >> 6));
    const int l15 = lane & 15, q4 = lane >> 4;
    const int b = sid >> 8, g = (sid >> 5) & 7, sseg = sid & 31;
    if (sseg == 0) return;
    LAS float* const X = (LAS float*)(lds + w * 4 * RG_WAVE_LDS);
    const f32x2* rgagg = (const f32x2*)(a.ws + WS_RGAGG);
    float hc[4];
#pragma unroll
    for (int tj = 0; tj < 4; ++tj) hc[tj] = 0.f;
    for (int sp0 = 0; sp0 < sseg; sp0 += 8) {
        f32x2 ag[8][4];
#pragma unroll
        for (int k = 0; k < 8; ++k)
#pragma unroll
            for (int tj = 0; tj < 4; ++tj) { const int sp = (sp0 + k < sseg) ? sp0 + k : sseg - 1; ag[k][tj] = rgagg[(size_t)(b * RG_NSEG + sp) * 512 + 64 * g + 16 * tj + l15]; }
#pragma unroll
        for (int k = 0; k < 8; ++k) { if (sp0 + k < sseg) {
#pragma unroll
                for (int tj = 0; tj < 4; ++tj) hc[tj] = ag[k][tj].x * hc[tj] + ag[k][tj].y; } }
    }
    if (q4 == 0) {
#pragma unroll
        for (int tj = 0; tj < 4; ++tj) X[16 * tj + l15] = hc[tj]; }
    const int t = lane >> 2, c0 = 8 * (lane & 3);
    f32x4 cv[4];
#pragma unroll
    for (int k = 0; k < 4; ++k) cv[k] = *(const LAS f32x4*)(X + c0 + 32 * (k >> 1) + 4 * (k & 1));
    const size_t row0 = (size_t)b * T_ + (size_t)sseg * RG_SEGLEN;
#pragma unroll 2
    for (int t4 = 0; t4 < 2; ++t4) {
        u32x4 yv[4][2], pv[4][2];
#pragma unroll
        for (int q = 0; q < 4; ++q) { const size_t r = row0 + 16 * (4 * t4 + q) + t;
            const bf16_t* yp = (const bf16_t*)(a.ws + WS_Y) + r * D_ + 64 * g + c0; const bf16_t* pq = (const bf16_t*)(a.ws + WS_PG) + r * 512 + 64 * g + c0;
            yv[q][0] = *(const u32x4*)yp; yv[q][1] = *(const u32x4*)(yp + 32); pv[q][0] = __builtin_nontemporal_load((const u32x4*)pq); pv[q][1] = __builtin_nontemporal_load((const u32x4*)(pq + 32)); }
#pragma unroll
        for (int q = 0; q < 4; ++q) { const size_t r = row0 + 16 * (4 * t4 + q) + t; bf16_t* yp = (bf16_t*)(a.ws + WS_Y) + r * D_ + 64 * g + c0;
#pragma unroll
            for (int hf = 0; hf < 2; ++hf) { u32x4 o;
#pragma unroll
                for (int j = 0; j < 4; ++j) { const f32x4 c = cv[2 * hf + (j >> 1)];
                    o[j] = pk_bf16(bf_lo(yv[q][hf][j]) + bf_lo(pv[q][hf][j]) * c[2 * (j & 1)], bf_hi(yv[q][hf][j]) + bf_hi(pv[q][hf][j]) * c[2 * (j & 1) + 1]); }
                *(u32x4*)(yp + 32 * hf) = o; } }
    }
}

#define XB_TMO      128
#define XB_XCNT(j)  (256  + 64 * (j))
#define XB_XSUB(j)  (1280 + 64 * (j))
#define XB_XGEN(j)  (2304 + 64 * (j))
#define XB_TOP      3328
#define XB_TOPGEN   3392
#define XCD_BAR_WORDS 3456
#define XB_SPIN_CAP (1u << 18)
DI unsigned xb_ld(unsigned* p)              { return __hip_atomic_load(p, __ATOMIC_RELAXED, __HIP_MEMORY_SCOPE_AGENT); }
DI unsigned xb_add(unsigned* p, unsigned v) { return __hip_atomic_fetch_add(p, v, __ATOMIC_RELAXED, __HIP_MEMORY_SCOPE_AGENT); }
DI unsigned xb_xcc_id() { return (unsigned)__builtin_amdgcn_s_getreg((3 << 11) | 20) & 0xFu; }
#define XB_SPIN(cond, bar) do { unsigned _sp = 0; while (cond) { __builtin_amdgcn_s_sleep(1); \
    if ((++_sp & 255u) == 0u) { if (xb_ld(&(bar)[XB_TMO])) break; if (_sp > XB_SPIN_CAP) { atomicAdd(&(bar)[XB_TMO], 1u); break; } } } } while (0)
struct XcdBarrier { unsigned* bar; unsigned x; volatile LAS unsigned* st; };
DI XcdBarrier xcd_barrier_post(unsigned* bar, volatile LAS unsigned* st) {
    XcdBarrier b; b.bar = bar; b.x = xb_xcc_id(); b.st = st;
    if (threadIdx.x == 0) (void)xb_add(&bar[XB_XCNT(b.x)], 1u);
    return b;
}
DI void xcd_barrier_complete(unsigned* bar, unsigned x, unsigned& nloc, unsigned& nx) {
    const unsigned G = gridDim.x * gridDim.y * gridDim.z;
    unsigned sum, cnt, mine, sp = 0u;
    for (;;) {
        sum = 0u; cnt = 0u; mine = 0u;
#pragma unroll
        for (unsigned j = 0; j < 16; ++j) { const unsigned c = xb_ld(&bar[XB_XCNT(j)]); sum += c; cnt += (c > 0u) ? 1u : 0u; mine = (j == x) ? c : mine; }
        if (sum == G) break;
        __builtin_amdgcn_s_sleep(1);
        if ((++sp & 255u) == 0u) { if (xb_ld(&bar[XB_TMO])) break; if (sp > XB_SPIN_CAP) { atomicAdd(&bar[XB_TMO], 1u); break; } }
    }
    nloc = mine > 0u ? mine : 1u; nx = cnt > 0u ? cnt : 1u;
}
DI void xcd_barrier(const XcdBarrier& b) {
    asm volatile("s_waitcnt vmcnt(0)" ::: "memory");
    __syncthreads();
    if (threadIdx.x == 0) {
        unsigned* bar = b.bar;
        __builtin_amdgcn_s_waitcnt(0);
        unsigned nloc = b.st[0], nx = b.st[1];
        if (nloc == 0u) { xcd_barrier_complete(bar, b.x, nloc, nx); b.st[0] = nloc; b.st[1] = nx; }
        const unsigned old = xb_add(&bar[XB_XSUB(b.x)], 1u);
        const unsigned gen = old / nloc;
        if (old + 1u == (gen + 1u) * nloc) {
            __builtin_amdgcn_fence(__ATOMIC_RELEASE, "agent");
            asm volatile("s_waitcnt vmcnt(0)" ::: "memory");
            const unsigned og = xb_add(&bar[XB_TOP], 1u);
            const unsigned tg = og / nx;
            if (og + 1u == (tg + 1u) * nx) xb_add(&bar[XB_TOPGEN], 1u);
            else XB_SPIN(xb_ld(&bar[XB_TOPGEN]) == tg, bar);
            __builtin_amdgcn_fence(__ATOMIC_ACQUIRE, "agent");
            xb_add(&bar[XB_XGEN(b.x)], 1u);
            asm volatile("s_waitcnt vmcnt(0)" ::: "memory");
        } else {
            XB_SPIN(xb_ld(&bar[XB_XGEN(b.x)]) == gen, bar);
            __builtin_amdgcn_fence(__ATOMIC_ACQUIRE, "agent");
            asm volatile("s_waitcnt vmcnt(0)" ::: "memory");
        }
    }
    __syncthreads();
}

__global__ void __launch_bounds__(512, 2) fwd_kernel(Args args) {
    extern __shared__ __attribute__((aligned(16))) unsigned char lds_raw[];
    LAS unsigned char* lds = (LAS unsigned char*)lds_raw;
    const int lo = args.ph_lo, hi = args.ph_hi;
    const int G = gridDim.x, bx = blockIdx.x;
#define IN(k) (lo <= (k) && (k) < hi)
    if (threadIdx.x < 4) *(LAS unsigned*)(lds + LDS_BARW + 4 * threadIdx.x) = 0u;
    __syncthreads();
    XcdBarrier bar; bar.bar = (unsigned*)(args.ws + WS_BAR); bar.x = 0; bar.st = nullptr;
    if (hi - lo > 1) bar = xcd_barrier_post((unsigned*)(args.ws + WS_BAR), (volatile LAS unsigned*)(lds + LDS_BARW));
    if (lo > hi) cg::this_grid().sync();
#define SEAM(k) do { if (IN(k) && IN((k) + 1)) { xcd_barrier(bar); } } while (0)
    if (IN(0)) { for (int rep = 0; rep < REP_P0; ++rep) p0_prologue(args, lds); for (int rep = 0; rep < REP_SYNC; ++rep) xcd_barrier(bar); }
    SEAM(0);
    if (IN(1)) {
        pg8::Gemm g{(const bf16_t*)(args.ws + WS_U), (const bf16_t*)(args.ws + WS_WIN), M_, DIN_, D_}; pg8::StaticOrder S; S.init(M_, DIN_, G, bx);
        pg8::EpiBf16<true> E{(bf16_t*)(args.ws + WS_PROJ), DIN_};
        for (int rep = 0; rep < REP_G1; ++rep) pg8::gemm_phase(lds, g, S, E);
    }
    SEAM(1);
    if (IN(2)) {
        for (int rep = 0; rep < REP_H; ++rep) for (int it = bx; it < 256; it += G) { const int seg = it & 7; if (seg < 7) hgrn_pass1(args, lds, it >> 5, (it >> 3) & 3, seg); }
        for (int sid = bx * 8 + (int)(threadIdx.x >> 6); sid < 2048; sid += G * 8) rg_pass1(args, lds, sid);
    }
    SEAM(2);
    if (IN(3)) {
        const bool fuse = (G == 256);
        for (int it = bx; it < 256; it += G) hgrn_item<true>(args, lds, it >> 5, (it >> 3) & 3, it & 7, fuse ? bx * 8 + (int)(threadIdx.x >> 6) : -1);
        if (!fuse) for (int sid = bx * 8 + (int)(threadIdx.x >> 6); sid < 2048; sid += G * 8) rg_pass2(args, lds, sid);
    }
    SEAM(3);
    if (IN(4)) {
        const bool pp_last = ((bx >> 3) & 1) != 0;
        if (!pp_last) { pg8::Gemm g{(const bf16_t*)(args.ws + WS_PB), (const bf16_t*)(args.ws + WS_WP), M_, D_, PLE_}; pg8::StaticOrder S; S.init(M_, D_, G, bx);
          pg8::EpiBf16<false> E{(bf16_t*)(args.ws + WS_PP), D_}; pg8::gemm_phase(lds, g, S, E); }
        { pg8::Gemm g{(const bf16_t*)(args.ws + WS_Y), (const bf16_t*)(args.ws + WS_WOUT), M_, D_, D_}; pg8::StaticOrder S; S.init(M_, D_, G, bx);
          pg8::EpiH E{(const bf16_t*)(args.ws + WS_U), (const float*)(args.ws + WS_RSX), (bf16_t*)(args.ws + WS_HB), (float*)(args.ws + WS_RSS1)}; pg8::gemm_phase(lds, g, S, E); }
        if (pp_last) { pg8::Gemm g{(const bf16_t*)(args.ws + WS_PB), (const bf16_t*)(args.ws + WS_WP), M_, D_, PLE_}; pg8::StaticOrder S; S.init(M_, D_, G, bx);
          pg8::EpiBf16<false> E{(bf16_t*)(args.ws + WS_PP), D_}; pg8::gemm_phase(lds, g, S, E); }
    }
    SEAM(4);
    if (IN(5)) {
        pg8::Gemm g{(const bf16_t*)(args.ws + WS_HB), (const bf16_t*)(args.ws + WS_WG), M_, D_, D_}; pg8::StaticOrder S; S.init(M_, D_, G, bx);
        pg8::EpiGate E{(bf16_t*)(args.ws + WS_Y), (const bf16_t*)(args.ws + WS_PP), args.in[16], (const float*)(args.ws + WS_RSS1)};
        pg8::gemm_phase(lds, g, S, E);
    }
    SEAM(5);
    if (IN(6)) {
        const u32x2* hb4 = (const u32x2*)(args.ws + WS_HB); const u32x2* gp4 = (const u32x2*)(args.ws + WS_Y); const f32x4* fw = (const f32x4*)args.in[18]; f32x4* o4 = (f32x4*)args.out;
        const int lane = threadIdx.x & 63, gw = bx * 8 + (int)(threadIdx.x >> 6), nw = G * 8;
        f32x4 wv[4];
#pragma unroll
        for (int sl = 0; sl < 4; ++sl) wv[sl] = fw[64 * sl + lane];
        for (int row = 4 * gw; row < M_; row += 4 * nw) {
            u32x2 hv[4][4], gv[4][4];
#pragma unroll
            for (int r = 0; r < 4; ++r)
#pragma unroll
                for (int sl = 0; sl < 4; ++sl) { const size_t i = (size_t)(row + r) * 256 + 64 * sl + lane; hv[r][sl] = __builtin_nontemporal_load(hb4 + i); gv[r][sl] = __builtin_nontemporal_load(gp4 + i); }
#pragma unroll
            for (int r = 0; r < 4; ++r) { f32x4 h2[4]; float ss = 0.f;
#pragma unroll
                for (int sl = 0; sl < 4; ++sl) { h2[sl] = (f32x4){bf_lo(hv[r][sl].x) + bf_lo(gv[r][sl].x), bf_hi(hv[r][sl].x) + bf_hi(gv[r][sl].x), bf_lo(hv[r][sl].y) + bf_lo(gv[r][sl].y), bf_hi(hv[r][sl].y) + bf_hi(gv[r][sl].y)};
                    ss += (h2[sl][0] * h2[sl][0] + h2[sl][1] * h2[sl][1]) + (h2[sl][2] * h2[sl][2] + h2[sl][3] * h2[sl][3]); }
#pragma unroll
                for (int o = 1; o < 64; o <<= 1) ss += __shfl_xor(ss, o);
                const float rstd = rsqrtf(ss * (1.0f / 1024.0f) + EPS_);
#pragma unroll
                for (int sl = 0; sl < 4; ++sl) __builtin_nontemporal_store(h2[sl] * rstd * wv[sl], o4 + (size_t)(row + r) * 256 + 64 * sl + lane); }
        }
    }
#undef IN
#undef SEAM
}

extern "C" void kernel_launch(void* const* d_in, const int* in_sizes, int n_in, void* d_out, int out_size, void* d_ws, size_t ws_size, hipStream_t stream) {
    static int grid = 0;
    if (grid == 0) {
        if (n_in != 19 || out_size != M_ * D_ || ws_size < WS_END) { fprintf(stderr, "kernel_launch: unexpected shapes (n_in %d out %d ws %zu need %zu)\n", n_in, out_size, ws_size, (size_t)WS_END); grid = -1; return; }
        int dev = 0, cus = 0, per_cu = 0;
        hipGetDevice(&dev); hipDeviceGetAttribute(&cus, hipDeviceAttributeMultiprocessorCount, dev);
        if (hipFuncSetAttribute((const void*)fwd_kernel, hipFuncAttributeMaxDynamicSharedMemorySize, LDS_BYTES) != hipSuccess) { fprintf(stderr, "kernel_launch: hipFuncSetAttribute failed\n"); grid = -1; return; }
        hipOccupancyMaxActiveBlocksPerMultiprocessor(&per_cu, (const void*)fwd_kernel, 512, LDS_BYTES);
        (void)hipGetLastError();
        if (per_cu < 1) per_cu = 1;
        grid = cus;
        fprintf(stderr, "kernel_launch: cus %d per_cu %d grid %d\n", cus, per_cu, grid);
    }
    if (grid < 0) return;
    Args a{};
    for (int i = 0; i < 19; ++i) a.in[i] = (const float*)d_in[i];
    a.out = (float*)d_out; a.ws = (unsigned char*)d_ws;
#if N_LAUNCHES == 1
    a.ph_lo = 0; a.ph_hi = 7;
    if (hipMemsetAsync((unsigned char*)d_ws + WS_BAR, 0, 16384, stream) != hipSuccess) { fprintf(stderr, "kernel_launch: memset of barrier words failed\n"); return; }
    void* kargs[] = {&a};
    hipError_t e = hipLaunchCooperativeKernel((const void*)fwd_kernel, dim3(grid), dim3(512), kargs, LDS_BYTES, stream);
    if (e != hipSuccess) fprintf(stderr, "cooperative launch failed: %s (grid %d)\n", hipGetErrorString(e), grid);
#else
    for (int ph = 0; ph < 7; ++ph) { a.ph_lo = ph; a.ph_hi = ph + 1; hipLaunchKernelGGL(fwd_kernel, dim3(grid), dim3(512), LDS_BYTES, stream, a); }
#endif
}
```

```cpp
#include <hip/hip_runtime.h>
#include <hip/hip_cooperative_groups.h>
#include <cstdio>
namespace cg = cooperative_groups;

#ifndef N_LAUNCHES
#define N_LAUNCHES 1
#endif

#define REP_G1 1
#define REP_P0 1
#define REP_SYNC 0
#define REP_G2 1
#define REP_G3 1
#define REP_G4 1
#define REP_H 1
#define REP_R 1
#ifndef CONC_BF16
#define CONC_BF16 false
#endif
#ifndef CONC_H
#define CONC_H true
#endif
#ifndef CONC_GATE
#define CONC_GATE true
#endif
#define LAS __attribute__((address_space(3)))
#define DI __device__ __forceinline__
typedef unsigned short bf16_t;
typedef short bf16x8 __attribute__((ext_vector_type(8)));
typedef float f32x2 __attribute__((ext_vector_type(2)));
typedef float f32x4 __attribute__((ext_vector_type(4)));
typedef float f32x16 __attribute__((ext_vector_type(16)));
typedef unsigned u32x2 __attribute__((ext_vector_type(2)));
typedef unsigned u32x4 __attribute__((ext_vector_type(4)));
typedef __bf16 bf16v2 __attribute__((ext_vector_type(2)));

DI unsigned pk_bf16(float lo, float hi) { bf16v2 v; v.x = (__bf16)lo; v.y = (__bf16)hi; return __builtin_bit_cast(unsigned, v); }
DI float bf_lo(unsigned w) { return __uint_as_float(w << 16); }
DI float bf_hi(unsigned w) { return __uint_as_float(w & 0xffff0000u); }
DI float bf1(bf16_t h) { return __uint_as_float(((unsigned)h) << 16); }
DI bf16_t f2bf(float f) { return (bf16_t)(pk_bf16(f, 0.f) & 0xffffu); }
DI float rcpf_(float x) { return __builtin_amdgcn_rcpf(x); }
DI float sigmoidf_(float z) { return rcpf_(1.0f + __expf(-z)); }

constexpr int M_ = 32768, D_ = 1024, DIN_ = 3072, T_ = 4096, PLE_ = 256;
constexpr int NSEG = 8, SEGLEN = 512;
constexpr int RG_NSEG = 32, RG_SEGLEN = 128;
constexpr float EPS_ = 1e-6f;
constexpr int COL_XA = 0, COL_GA = 512, COL_QB = 1024, COL_FB = 1536, COL_IB = 2048, COL_GB = 2560;

constexpr size_t WS_RSS1 = 0;
constexpr size_t WS_RSS2 = WS_RSS1 + (size_t)M_ * 4;
constexpr size_t WS_WIN = WS_RSS2 + (size_t)M_ * 4;
constexpr size_t WS_WOUT = WS_WIN + (size_t)3072 * 1024 * 2;
constexpr size_t WS_WG = WS_WOUT + (size_t)1024 * 1024 * 2;
constexpr size_t WS_WP = WS_WG + (size_t)1024 * 1024 * 2;
constexpr size_t WS_WRG = WS_WP + (size_t)1024 * 256 * 2;
constexpr size_t WS_RGAGG = WS_WRG + (size_t)2 * 8 * 64 * 64 * 2;
constexpr size_t WS_DSEG = WS_RGAGG + (size_t)8 * 32 * 512 * 8;
constexpr size_t WS_SSEG = WS_DSEG + (size_t)256 * 128 * 4;
constexpr size_t WS_U = WS_SSEG + (size_t)256 * 16384 * 4;
constexpr size_t WS_PB = WS_U + (size_t)M_ * 1024 * 2;
constexpr size_t WS_PROJ = WS_PB + (size_t)M_ * 256 * 2;
constexpr size_t WS_Y = WS_PROJ + (size_t)M_ * 3072 * 2;
constexpr size_t WS_HB = WS_Y + (size_t)M_ * 1024 * 2;
constexpr size_t WS_PP = WS_HB + (size_t)M_ * 1024 * 2;
constexpr size_t WS_PG = WS_PP;
constexpr size_t WS_BAR = WS_PP + (size_t)M_ * 1024 * 2;
constexpr size_t WS_RSX = WS_BAR + 16384;
constexpr size_t WS_END = WS_RSX + (size_t)M_ * 4;

DI size_t pidx(size_t row, int col) { return ((size_t)(col >> 7) * M_ + row) * 128 + (size_t)(col & 127); }
constexpr int LDS_BYTES = 144384;
constexpr int LDS_BARW = 144368;

struct Args { const float* in[19]; float* out; unsigned char* ws; int ph_lo, ph_hi; };

namespace pg8 {
constexpr int BM = 256, BK = 64, HALF = 128, HTB = HALF * BK * 2, STAGE_BYTES = 8 * HTB, NXCD = 8, WGM = 8;
DI int lds_byte(int r, int c) { const int st = (r >> 4) * 2 + (c >> 5), rr = r & 15, cc = c & 31, ob = rr * 64 + cc * 2; return st * 1024 + (ob ^ (((ob >> 9) & 1) << 5)); }
DI void stage_rc(int b, int& R, int& C) { const int st = b / 1024, sb = b % 1024, swz = sb ^ (((sb >> 9) & 1) << 5); R = (st >> 1) * 16 + swz / 64; C = (st & 1) * 32 + (swz % 64) / 2; }
DI int perm32(int rho) { const int n = rho >> 4, i = rho & 15; return 8 * (i >> 2) + 4 * n + (i & 3); }
struct Unit { int pm, pn; };
struct Gemm { const bf16_t* A; const bf16_t* Bt; int M, N, K; };
struct StaticOrder {
    int nM, nN, nwg, G, c;
    DI void init(int M, int N, int G_, int c_) { nM = M / BM; nN = N / BM; nwg = nM * nN; G = G_; c = c_; }
    DI bool next(int i, Unit& u) const {
        const long L = (long)i * G + c; if (L >= nwg) return false;
        int wgid = (int)L; { const int q = nwg / NXCD, r = nwg % NXCD, xcd = wgid % NXCD, off = wgid / NXCD; wgid = (xcd < r ? xcd * (q + 1) : r * (q + 1) + (xcd - r) * q) + off; }
        const int nig = WGM * nN, gid = wgid / nig, fm = gid * WGM, gsz = (nM - fm) < WGM ? (nM - fm) : WGM;
        u.pm = fm + ((wgid % nig) % gsz); u.pn = (wgid % nig) / gsz; return true;
    }
};
template <bool BLK> struct EpiBf16 {
    static constexpr bool PERM = true, CONC = CONC_BF16;
    bf16_t* O; int ldc;
    DI void operator()(const f32x4 (&acc)[2][2][4][2], const Unit& u, int wr, int wc, int fr, int fq) const {
        const int row0 = u.pm * BM + wr * 64 + fr, col0 = u.pn * BM + wc * 32 + 8 * fq;
#pragma unroll
        for (int ai = 0; ai < 2; ++ai)
#pragma unroll
            for (int m = 0; m < 4; ++m) { const int row = row0 + ai * HALF + m * 16;
#pragma unroll
                for (int bj = 0; bj < 2; ++bj) { const f32x4 v0 = acc[ai][bj][m][0], v1 = acc[ai][bj][m][1];
                    u32x4 w; w.x = pk_bf16(v0[0], v0[1]); w.y = pk_bf16(v0[2], v0[3]); w.z = pk_bf16(v1[0], v1[1]); w.w = pk_bf16(v1[2], v1[3]);
                    bf16_t* dst = BLK ? O + pidx((size_t)row, col0 + bj * HALF) : O + (size_t)row * ldc + col0 + bj * HALF;
                    *(u32x4*)dst = w; } }
    }
};
struct EpiH {
    static constexpr bool PERM = true, CONC = CONC_H;
    const bf16_t* ub; const float* rinv; bf16_t* hb; float* rss;
    DI void operator()(const f32x4 (&acc)[2][2][4][2], const Unit& u, int wr, int wc, int fr, int fq) const {
        const int row0 = u.pm * BM + wr * 64 + fr, col0 = u.pn * BM + wc * 32 + 8 * fq;
#pragma unroll
        for (int ai = 0; ai < 2; ++ai) {
            u32x4 xw[4][2]; float ri[4];
#pragma unroll
            for (int m = 0; m < 4; ++m) { const int row = row0 + ai * HALF + m * 16; ri[m] = rinv[row];
#pragma unroll
                for (int bj = 0; bj < 2; ++bj) xw[m][bj] = __builtin_nontemporal_load((const u32x4*)(ub + (size_t)row * D_ + col0 + bj * HALF)); }
#pragma unroll
            for (int m = 0; m < 4; ++m) { const int row = row0 + ai * HALF + m * 16; float ss = 0.f; const float rv = ri[m];
#pragma unroll
                for (int bj = 0; bj < 2; ++bj) { const size_t off = (size_t)row * D_ + col0 + bj * HALF; const u32x4 q = xw[m][bj];
                    const f32x4 x0 = (f32x4){bf_lo(q.x), bf_hi(q.x), bf_lo(q.y), bf_hi(q.y)}, x1 = (f32x4){bf_lo(q.z), bf_hi(q.z), bf_lo(q.w), bf_hi(q.w)};
                    const f32x4 v0 = acc[ai][bj][m][0] + x0 * rv, v1 = acc[ai][bj][m][1] + x1 * rv;
                    u32x4 w; w.x = pk_bf16(v0[0], v0[1]); w.y = pk_bf16(v0[2], v0[3]); w.z = pk_bf16(v1[0], v1[1]); w.w = pk_bf16(v1[2], v1[3]);
                    *(u32x4*)(hb + off) = w;
                    ss += (v0[0] * v0[0] + v0[1] * v0[1]) + (v0[2] * v0[2] + v0[3] * v0[3]) + (v1[0] * v1[0] + v1[1] * v1[1]) + (v1[2] * v1[2] + v1[3] * v1[3]); }
                ss += __shfl_xor(ss, 16); ss += __shfl_xor(ss, 32);
                if (fq == 0) unsafeAtomicAdd(rss + row, ss); }
        }
    }
};
struct EpiGate {
    static constexpr bool PERM = true, CONC = CONC_GATE;
    bf16_t* gpo; const bf16_t* pp; const float* bg; const float* rss1;
    DI void operator()(const f32x4 (&acc)[2][2][4][2], const Unit& u, int wr, int wc, int fr, int fq) const {
        const int row0 = u.pm * BM + wr * 64 + fr, col0 = u.pn * BM + wc * 32 + 8 * fq;
        f32x4 bv[2][2];
#pragma unroll
        for (int bj = 0; bj < 2; ++bj) { bv[bj][0] = *(const f32x4*)(bg + col0 + bj * HALF) * (-1.44269504f); bv[bj][1] = *(const f32x4*)(bg + col0 + bj * HALF + 4) * (-1.44269504f); }
#pragma unroll
        for (int ai = 0; ai < 2; ++ai) {
            u32x4 pw[4][2]; float rs[4];
#pragma unroll
            for (int m = 0; m < 4; ++m) { const int row = row0 + ai * HALF + m * 16; rs[m] = rss1[row];
#pragma unroll
                for (int bj = 0; bj < 2; ++bj) pw[m][bj] = __builtin_nontemporal_load((const u32x4*)(pp + (size_t)row * D_ + col0 + bj * HALF)); }
#pragma unroll
            for (int m = 0; m < 4; ++m) { const int row = row0 + ai * HALF + m * 16;
                const float rl = rsqrtf(rs[m] * (1.0f / 1024.0f) + EPS_) * (-1.44269504f);
#pragma unroll
                for (int bj = 0; bj < 2; ++bj) { const size_t off = (size_t)row * D_ + col0 + bj * HALF; const u32x4 pq = pw[m][bj];
                    const f32x4 p0 = (f32x4){bf_lo(pq.x), bf_hi(pq.x), bf_lo(pq.y), bf_hi(pq.y)}, p1 = (f32x4){bf_lo(pq.z), bf_hi(pq.z), bf_lo(pq.w), bf_hi(pq.w)};
                    f32x4 z0 = acc[ai][bj][m][0] * rl + bv[bj][0], z1 = acc[ai][bj][m][1] * rl + bv[bj][1];
#pragma unroll
                    for (int j = 0; j < 4; ++j) { z0[j] = __builtin_amdgcn_exp2f(z0[j]); z1[j] = __builtin_amdgcn_exp2f(z1[j]); }
                    z0 = z0 + 1.0f; z1 = z1 + 1.0f;
#pragma unroll
                    for (int j = 0; j < 4; ++j) { z0[j] = rcpf_(z0[j]); z1[j] = rcpf_(z1[j]); }
                    const f32x4 v0 = z0 * p0, v1 = z1 * p1;
                    u32x4 w; w.x = pk_bf16(v0[0], v0[1]); w.y = pk_bf16(v0[2], v0[3]); w.z = pk_bf16(v1[0], v1[1]); w.w = pk_bf16(v1[2], v1[3]);
                    *(u32x4*)(gpo + off) = w; } }
        }
    }
};

template <class Epi, class Sched>
DI void gemm_phase(LAS unsigned char* lds, const Gemm g, const Sched& S, const Epi& E) {
    const int tid = threadIdx.x, wid = __builtin_amdgcn_readfirstlane(tid >> 6), lane = tid & 63, wr = wid >> 2, wc = wid & 3, fr = lane & 15, fq = lane >> 4;
    const int K = g.K, nt = K / BK;
    unsigned voffA[2], voffB[2];
#pragma unroll
    for (int i = 0; i < 2; ++i) { int R, C; stage_rc(tid * 16 + i * 8192, R, C); const int Rb = Epi::PERM ? ((R & ~31) + perm32(R & 31)) : R;
        voffA[i] = (unsigned)(R * K + C) * 2u; voffB[i] = (unsigned)(Rb * K + C) * 2u; }
    const size_t kstep = (size_t)(BK * 2);
    const size_t hstep = (size_t)HALF * K * 2;
    const size_t tstep = 2 * hstep;
    const unsigned ldsw = (unsigned)wid * 1024u;
    const int aoff = lds_byte(wr * 64 + fr, fq * 8), boff = lds_byte(wc * 32 + fr, fq * 8);
#define PG8_SA(b, h) (((b) * 2 + (h)) * HTB)
#define PG8_SB(b, h) ((4 + (b) * 2 + (h)) * HTB)
#define PG8_STAGE(bufoff, gbase, voff) do { _Pragma("unroll") for (int _i = 0; _i < 2; ++_i) \
        __builtin_amdgcn_global_load_lds((const unsigned*)((const char*)(gbase) + (voff)[_i]), (LAS unsigned*)(lds + (bufoff) + ldsw + _i * 8192), 16, 0, 0); } while (0)
#define PG8_LDA(dst, b, h) do { _Pragma("unroll") for (int m = 0; m < 4; ++m) _Pragma("unroll") for (int k = 0; k < 2; ++k) dst[m][k] = *(const LAS bf16x8*)(lds + PG8_SA(b, h) + aoff + m * 2048 + k * 1024); } while (0)
#define PG8_LDB(dst, b, h) do { _Pragma("unroll") for (int n = 0; n < 2; ++n) _Pragma("unroll") for (int k = 0; k < 2; ++k) dst[n][k] = *(const LAS bf16x8*)(lds + PG8_SB(b, h) + boff + n * 2048 + k * 1024); } while (0)
#define PG8_MMA(ai, bj, At, Bt) do { __builtin_amdgcn_s_setprio(1); _Pragma("unroll") for (int m = 0; m < 4; ++m) _Pragma("unroll") for (int n = 0; n < 2; ++n) _Pragma("unroll") for (int k = 0; k < 2; ++k) \
        acc[ai][bj][m][n] = __builtin_amdgcn_mfma_f32_16x16x32_bf16(Bt[n][k], At[m][k], acc[ai][bj][m][n], 0, 0, 0); __builtin_amdgcn_s_setprio(0); } while (0)
#define PG8_WAIT_V(n) asm volatile("s_waitcnt vmcnt(" #n ")" ::: "memory")
#define PG8_WAIT_L(n) asm volatile("s_waitcnt lgkmcnt(" #n ")" ::: "memory")
#define PG8_BAR __builtin_amdgcn_s_barrier()
#define PG8_SCHED __builtin_amdgcn_sched_barrier(0)
    Unit cur, nxt; int ui = 0;
    if (!S.next(0, cur)) return;
    f32x4 acc[2][2][4][2];
#pragma unroll
    for (int a = 0; a < 2; ++a)
#pragma unroll
        for (int b = 0; b < 2; ++b)
#pragma unroll
            for (int m = 0; m < 4; ++m)
#pragma unroll
                for (int n = 0; n < 2; ++n) acc[a][b][m][n] = (f32x4){0.f, 0.f, 0.f, 0.f};
    bf16x8 At[4][2], B0[2][2], B1[2][2];
    const char* cA = (const char*)g.A + (size_t)cur.pm * tstep; const char* cB = (const char*)g.Bt + (size_t)cur.pn * tstep;
    PG8_STAGE(PG8_SB(0, 0), cB, voffB); PG8_STAGE(PG8_SA(0, 0), cA, voffA); PG8_STAGE(PG8_SB(0, 1), cB + hstep, voffB); PG8_STAGE(PG8_SA(0, 1), cA + hstep, voffA);
    if (wr == 1) PG8_BAR;
    PG8_WAIT_V(4); PG8_BAR;
    PG8_STAGE(PG8_SB(1, 0), cB + kstep, voffB); PG8_STAGE(PG8_SA(1, 0), cA + kstep, voffA); PG8_STAGE(PG8_SB(1, 1), cB + hstep + kstep, voffB);
    PG8_WAIT_V(6); PG8_BAR;
    for (;;) {
        const bool has_next = S.next(ui + 1, nxt);
        const char* nA = has_next ? (const char*)g.A + (size_t)nxt.pm * tstep : cA; const char* nB = has_next ? (const char*)g.Bt + (size_t)nxt.pn * tstep : cB;
        for (int t = 0; t < nt; t += 2) {
            const bool last = (t == nt - 2);
            const char* a1 = cA + (size_t)(t + 1) * kstep;
            const char* a2 = last ? nA : cA + (size_t)(t + 2) * kstep; const char* b2 = last ? nB : cB + (size_t)(t + 2) * kstep;
            const char* a3 = a2 + kstep; const char* b3 = b2 + kstep;
            PG8_LDB(B0, 0, 0); PG8_SCHED; PG8_LDA(At, 0, 0); PG8_STAGE(PG8_SA(1, 1), a1 + hstep, voffA);
            PG8_WAIT_L(8); PG8_BAR; PG8_WAIT_L(0); PG8_MMA(0, 0, At, B0); PG8_BAR; PG8_SCHED;
            PG8_LDB(B1, 0, 1); PG8_STAGE(PG8_SB(0, 0), b2, voffB);
            PG8_BAR; PG8_WAIT_L(0); PG8_MMA(0, 1, At, B1); PG8_BAR;
            PG8_LDA(At, 0, 1); PG8_STAGE(PG8_SA(0, 0), a2, voffA);
            PG8_BAR; PG8_WAIT_L(0); PG8_MMA(1, 0, At, B0); PG8_BAR; PG8_SCHED;
            PG8_STAGE(PG8_SB(0, 1), b2 + hstep, voffB);
            PG8_WAIT_V(6); PG8_BAR; PG8_MMA(1, 1, At, B1); PG8_BAR;
            PG8_LDB(B0, 1, 0); PG8_SCHED; PG8_LDA(At, 1, 0); PG8_STAGE(PG8_SA(0, 1), a2 + hstep, voffA);
            PG8_WAIT_L(8); PG8_BAR; PG8_WAIT_L(0); PG8_MMA(0, 0, At, B0); PG8_BAR; PG8_SCHED;
            PG8_LDB(B1, 1, 1); PG8_STAGE(PG8_SB(1, 0), b3, voffB);
            PG8_BAR; PG8_WAIT_L(0); PG8_MMA(0, 1, At, B1); PG8_BAR;
            PG8_LDA(At, 1, 1); PG8_STAGE(PG8_SA(1, 0), a3, voffA);
            PG8_BAR; PG8_WAIT_L(0); PG8_MMA(1, 0, At, B0); PG8_BAR; PG8_SCHED;
            PG8_STAGE(PG8_SB(1, 1), b3 + hstep, voffB);
            PG8_WAIT_V(6); PG8_BAR; PG8_MMA(1, 1, At, B1); PG8_BAR;
        }
        if (Epi::CONC && wr == 0) PG8_BAR;
        E(acc, cur, wr, wc, fr, fq);
        if (Epi::CONC && wr == 1) PG8_BAR;
        if (!has_next) break;
#pragma unroll
        for (int a = 0; a < 2; ++a)
#pragma unroll
            for (int b = 0; b < 2; ++b)
#pragma unroll
                for (int m = 0; m < 4; ++m)
#pragma unroll
                    for (int n = 0; n < 2; ++n) acc[a][b][m][n] = (f32x4){0.f, 0.f, 0.f, 0.f};
        cur = nxt; cA = nA; cB = nB; ++ui;
    }
    PG8_WAIT_V(0);
    if (wr == 0) PG8_BAR;
    PG8_BAR;
#undef PG8_SA
#undef PG8_SB
#undef PG8_STAGE
#undef PG8_LDA
#undef PG8_LDB
#undef PG8_MMA
#undef PG8_WAIT_V
#undef PG8_WAIT_L
#undef PG8_BAR
#undef PG8_SCHED
}
}

DI void p0_prologue(const Args& a, LAS unsigned char* lds) {
    const int tid = threadIdx.x, lane = tid & 63, wave = __builtin_amdgcn_readfirstlane(tid >> 6);
    const int gtid = blockIdx.x * 512 + tid, gsz = gridDim.x * 512;
    const int gw = blockIdx.x * 8 + wave, nw = gridDim.x * 8;
    float* rss = (float*)(a.ws + WS_RSS1);
    for (int i = gtid; i < 2 * M_; i += gsz) rss[i] = 0.f;
    {
        LAS float* tile = (LAS float*)(lds + wave * 16640);
        for (int tix = gw; tix < 1344; tix += nw) {
            const float* W; const float* sc; bf16_t* O; int K, N, kt, nt;
            if (tix < 768) { W = a.in[3]; sc = a.in[2]; O = (bf16_t*)(a.ws + WS_WIN); K = 1024; N = 3072; kt = tix / 48; nt = tix % 48; }
            else if (tix < 1024) { const int t = tix - 768; W = a.in[13]; sc = nullptr; O = (bf16_t*)(a.ws + WS_WOUT); K = 1024; N = 1024; kt = t / 16; nt = t % 16; }
            else if (tix < 1280) { const int t = tix - 1024; W = a.in[15]; sc = a.in[14]; O = (bf16_t*)(a.ws + WS_WG); K = 1024; N = 1024; kt = t / 16; nt = t % 16; }
            else { const int t = tix - 1280; W = a.in[17]; sc = nullptr; O = (bf16_t*)(a.ws + WS_WP); K = 256; N = 1024; kt = t / 16; nt = t % 16; }
            const int r = lane >> 4, c4 = lane & 15;
            f32x4 v[16];
#pragma unroll
            for (int i = 0; i < 16; ++i) v[i] = *(const f32x4*)(W + (size_t)(kt * 64 + 4 * i + r) * N + nt * 64 + 4 * c4);
#pragma unroll
            for (int i = 0; i < 16; ++i) { const int kl = 4 * i + r; const float sv = sc ? sc[kt * 64 + kl] : 1.0f;
#pragma unroll
                for (int j = 0; j < 4; ++j) tile[kl * 65 + 4 * c4 + j] = v[i][j] * sv; }
#pragma unroll
            for (int it = 0; it < 8; ++it) { const int n = 8 * it + (lane >> 3), kq = lane & 7; float t8[8];
#pragma unroll
                for (int i = 0; i < 8; ++i) t8[i] = tile[(8 * kq + i) * 65 + n];
                u32x4 o; o.x = pk_bf16(t8[0], t8[1]); o.y = pk_bf16(t8[2], t8[3]); o.z = pk_bf16(t8[4], t8[5]); o.w = pk_bf16(t8[6], t8[7]);
                *(u32x4*)(O + (size_t)(nt * 64 + n) * K + kt * 64 + 8 * kq) = o; }
        }
    }
    {
        bf16_t* wrg = (bf16_t*)(a.ws + WS_WRG);
        for (int i = gtid; i < 65536; i += gsz) { const int mat = i >> 15, g = (i >> 12) & 7, j = (i >> 6) & 63, ii = i & 63;
            const float* src = mat ? a.in[8] : a.in[6]; wrg[i] = f2bf(src[(g * 64 + ii) * 64 + j] * (-1.44269504f)); }
    }
    {
        for (int row = 2 * gw; row < M_; row += 2 * nw) {
            const f32x4* xr = (const f32x4*)(a.in[0] + (size_t)row * D_);
            f32x4 v[8]; float ss0 = 0.f, ss1 = 0.f;
#pragma unroll
            for (int i = 0; i < 8; ++i) v[i] = __builtin_nontemporal_load(xr + lane + 64 * i);
#pragma unroll
            for (int i = 0; i < 4; ++i) { ss0 += (v[i][0] * v[i][0] + v[i][1] * v[i][1]) + (v[i][2] * v[i][2] + v[i][3] * v[i][3]); ss1 += (v[4 + i][0] * v[4 + i][0] + v[4 + i][1] * v[4 + i][1]) + (v[4 + i][2] * v[4 + i][2] + v[4 + i][3] * v[4 + i][3]); }
#pragma unroll
            for (int o = 1; o < 64; o <<= 1) { ss0 += __shfl_xor(ss0, o); ss1 += __shfl_xor(ss1, o); }
            const float r0 = rsqrtf(ss0 * (1.0f / 1024.0f) + EPS_), r1 = rsqrtf(ss1 * (1.0f / 1024.0f) + EPS_);
            if (lane == 0) { float* rsx = (float*)(a.ws + WS_RSX); rsx[row] = sqrtf(ss0 * (1.0f / 1024.0f) + EPS_); rsx[row + 1] = sqrtf(ss1 * (1.0f / 1024.0f) + EPS_); }
            u32x2* ur = (u32x2*)(a.ws + WS_U + (size_t)row * 2048);
#pragma unroll
            for (int i = 0; i < 8; ++i) { const float rr = (i < 4) ? r0 : r1; u32x2 o; o.x = pk_bf16(v[i][0] * rr, v[i][1] * rr); o.y = pk_bf16(v[i][2] * rr, v[i][3] * rr); ur[lane + 64 * i] = o; }
        }
    }
}

constexpr int HG_QE = 0, HG_KE = 17408, HG_KDT = 34816, HG_VT = 53248, HG_SB = 71680, HG_P = 106496, HG_OB = 115712, HG_TOT = 133120, HG_DEC = 137216, HG_PART = 137728;
#define MFMA32(a, b, c) __builtin_amdgcn_mfma_f32_32x32x16_bf16((a), (b), (c), 0, 0, 0)
#define MFMA16(a, b, c) __builtin_amdgcn_mfma_f32_16x16x32_bf16((a), (b), (c), 0, 0, 0)

template <bool PASS2>
DI void hgrn_item(const Args& a, LAS unsigned char* lds, int b, int h, int seg, int fuse_sid = -1) {
    const int tid = threadIdx.x, lane = tid & 63, w = __builtin_amdgcn_readfirstlane(tid >> 6);
    const int l31 = lane & 31, hh = lane >> 5, l15 = lane & 15, q4 = lane >> 4;
    const bf16_t* proj = (const bf16_t*)(a.ws + WS_PROJ);
    const int item = (b * 4 + h) * NSEG + seg;
    const int k0 = 2 * lane;
    const float* hglb = a.in[11];
    const float lb0 = rcpf_(1.0f + __expf(hglb[512 + 128 * h + k0] - hglb[128 * h + k0]));
    const float lb1 = rcpf_(1.0f + __expf(hglb[512 + 128 * h + k0 + 1] - hglb[128 * h + k0 + 1]));
    const int kt = w >> 1;
    f32x16 S[2];
#pragma unroll
    for (int i = 0; i < 2; ++i)
#pragma unroll
        for (int r = 0; r < 16; ++r) S[i][r] = 0.f;
    float* sseg = (float*)(a.ws + WS_SSEG); float* dseg = (float*)(a.ws + WS_DSEG);
    if (PASS2) {
        for (int sp = 0; sp < seg; ++sp) { const int it2 = item - seg + sp;
            const float* E = sseg + (size_t)it2 * 16384 + (size_t)w * 2048 + lane; const float* Dp = dseg + it2 * 128 + 32 * kt + 4 * hh;
#pragma unroll
            for (int g = 0; g < 4; ++g) { const f32x4 d = *(const f32x4*)(Dp + 8 * g);
#pragma unroll
                for (int i = 0; i < 2; ++i)
#pragma unroll
                    for (int j = 0; j < 4; ++j) S[i][4 * g + j] = S[i][4 * g + j] * d[j] + E[(i * 16 + 4 * g + j) * 64]; }
        }
    }
    float segtot0 = 0.f, segtot1 = 0.f;
    const size_t row0 = (size_t)b * T_ + (size_t)seg * SEGLEN;
    const bool rgdo = PASS2 && fuse_sid >= 0 && (fuse_sid & 31) != 0;
    const int rg_g = (fuse_sid >> 5) & 7;
    const size_t rg_row0 = (size_t)(fuse_sid >> 8) * T_ + (size_t)(fuse_sid & 31) * RG_SEGLEN;
    if (rgdo) {
        const int rb_ = fuse_sid >> 8, sseg = fuse_sid & 31; const f32x2* rgagg = (const f32x2*)(a.ws + WS_RGAGG);
        float hc[4];
#pragma unroll
        for (int tj = 0; tj < 4; ++tj) hc[tj] = 0.f;
        for (int sp0 = 0; sp0 < sseg; sp0 += 4) {
            f32x2 ag[4][4];
#pragma unroll
            for (int k = 0; k < 4; ++k)
#pragma unroll
                for (int tj = 0; tj < 4; ++tj) { const int sp = (sp0 + k < sseg) ? sp0 + k : sseg - 1; ag[k][tj] = rgagg[(size_t)(rb_ * RG_NSEG + sp) * 512 + 64 * rg_g + 16 * tj + l15]; }
#pragma unroll
            for (int k = 0; k < 4; ++k) { if (sp0 + k < sseg) {
#pragma unroll
                    for (int tj = 0; tj < 4; ++tj) hc[tj] = ag[k][tj].x * hc[tj] + ag[k][tj].y; } }
        }
        LAS float* const Xc = (LAS float*)(lds + 139264 + w * 256);
        if (q4 == 0) {
#pragma unroll
            for (int tj = 0; tj < 4; ++tj) Xc[16 * tj + l15] = hc[tj]; }
    }
    f32x4 nwv[4];
#pragma unroll
    for (int j = 0; j < 4; ++j) nwv[j] = *(const f32x4*)(a.in[12] + 8 * (tid & 7) + 64 * (j >> 1) + 4 * (j & 1));
    unsigned fzn[8], vn[8], qn[8];
#pragma unroll
    for (int i = 0; i < 8; ++i) { const size_t rr = row0 + 8 * w + i;
        fzn[i] = *(const unsigned*)(proj + pidx(rr, COL_FB + 128 * h) + k0); vn[i] = *(const unsigned*)(proj + pidx(rr, COL_IB + 128 * h) + k0); if (PASS2) qn[i] = *(const unsigned*)(proj + pidx(rr, COL_QB + 128 * h) + k0); }
    for (int c = 0; c < 8; ++c) {
        const size_t rb = row0 + 64 * c;
        unsigned fzw[8], vw[8], qw[8];
#pragma unroll
        for (int i = 0; i < 8; ++i) { fzw[i] = fzn[i]; vw[i] = vn[i]; if (PASS2) qw[i] = qn[i]; }
        if (c < 7) {
#pragma unroll
            for (int i = 0; i < 8; ++i) { const size_t rr = rb + 64 + 8 * w + i;
                fzn[i] = *(const unsigned*)(proj + pidx(rr, COL_FB + 128 * h) + k0); vn[i] = *(const unsigned*)(proj + pidx(rr, COL_IB + 128 * h) + k0); if (PASS2) qn[i] = *(const unsigned*)(proj + pidx(rr, COL_QB + 128 * h) + k0); } }
        u32x4 gpa, gpb;
        if (PASS2) { const bf16_t* gp = proj + pidx(rb + (tid >> 3), COL_GB + 128 * h) + 8 * (tid & 7); gpa = *(const u32x4*)gp; gpb = *(const u32x4*)(gp + 64); }
        float bl0[8], bl1[8], kk0[8], kk1[8]; float c0 = 0.f, c1 = 0.f;
#pragma unroll
        for (int i = 0; i < 8; ++i) {
            const float z0 = bf_lo(fzw[i]), z1 = bf_hi(fzw[i]);
            const float e0 = __expf(-z0), e1 = __expf(-z1);
            const float s0 = rcpf_(1.0f + e0), s1 = rcpf_(1.0f + e1);
            const float f0 = lb0 + (1.0f - lb0) * s0, f1 = lb1 + (1.0f - lb1) * s1;
            c0 += __logf(f0); c1 += __logf(f1); bl0[i] = c0; bl1[i] = c1;
            kk0[i] = (1.0f - lb0) * e0 * s0; kk1[i] = (1.0f - lb1) * e1 * s1;
        }
        *(LAS f32x2*)(lds + HG_TOT + (w * 128 + k0) * 4) = (f32x2){c0, c1};
        if (PASS2) {
#pragma unroll
            for (int i = 0; i < 2; ++i) { const int v = 32 * ((w & 1) * 2 + i) + l31;
#pragma unroll
                for (int g = 0; g < 4; ++g) { u32x2 o; o.x = pk_bf16(S[i][4 * g], S[i][4 * g + 1]); o.y = pk_bf16(S[i][4 * g + 2], S[i][4 * g + 3]);
                    *(LAS u32x2*)(lds + HG_SB + v * 272 + (32 * kt + 8 * g + 4 * hh) * 2) = o; } }
        }
        __syncthreads();
        float pre0 = 0.f, pre1 = 0.f, tot0 = 0.f, tot1 = 0.f;
#pragma unroll
        for (int g = 0; g < 8; ++g) { const f32x2 t = *(const LAS f32x2*)(lds + HG_TOT + (g * 128 + k0) * 4); if (g < w) { pre0 += t.x; pre1 += t.y; } tot0 += t.x; tot1 += t.y; }
        segtot0 += tot0; segtot1 += tot1;
        {
            float kd0[8], kd1[8];
#pragma unroll
            for (int i = 0; i < 8; ++i) {
                const float bb0 = pre0 + bl0[i], bb1 = pre1 + bl1[i];
                kd0[i] = kk0[i] * __expf(tot0 - bb0); kd1[i] = kk1[i] * __expf(tot1 - bb1);
                if (PASS2) {
                    const float eb0 = __expf(bb0), eb1 = __expf(bb1);
                    const float q0 = bf_lo(qw[i]), q1 = bf_hi(qw[i]);
                    const float qs0 = q0 * sigmoidf_(q0) * 0.08838834764831845f, qs1 = q1 * sigmoidf_(q1) * 0.08838834764831845f;
                    const int t = 8 * w + i;
                    *(LAS unsigned*)(lds + HG_QE + t * 272 + k0 * 2) = pk_bf16(qs0 * eb0, qs1 * eb1);
                    *(LAS unsigned*)(lds + HG_KE + t * 272 + k0 * 2) = pk_bf16(kk0[i] * rcpf_(eb0), kk1[i] * rcpf_(eb1));
                }
            }
            u32x4 o0, o1, p0, p1;
            o0.x = pk_bf16(kd0[0], kd0[1]); o0.y = pk_bf16(kd0[2], kd0[3]); o0.z = pk_bf16(kd0[4], kd0[5]); o0.w = pk_bf16(kd0[6], kd0[7]);
            o1.x = pk_bf16(kd1[0], kd1[1]); o1.y = pk_bf16(kd1[2], kd1[3]); o1.z = pk_bf16(kd1[4], kd1[5]); o1.w = pk_bf16(kd1[6], kd1[7]);
            p0.x = (vw[0] & 0xffffu) | (vw[1] << 16); p0.y = (vw[2] & 0xffffu) | (vw[3] << 16); p0.z = (vw[4] & 0xffffu) | (vw[5] << 16); p0.w = (vw[6] & 0xffffu) | (vw[7] << 16);
            p1.x = (vw[0] >> 16) | (vw[1] & 0xffff0000u); p1.y = (vw[2] >> 16) | (vw[3] & 0xffff0000u); p1.z = (vw[4] >> 16) | (vw[5] & 0xffff0000u); p1.w = (vw[6] >> 16) | (vw[7] & 0xffff0000u);
            *(LAS u32x4*)(lds + HG_KDT + k0 * 144 + 16 * w) = o0; *(LAS u32x4*)(lds + HG_KDT + (k0 + 1) * 144 + 16 * w) = o1;
            *(LAS u32x4*)(lds + HG_VT + k0 * 144 + 16 * w) = p0; *(LAS u32x4*)(lds + HG_VT + (k0 + 1) * 144 + 16 * w) = p1;
            if (w == 0) *(LAS f32x2*)(lds + HG_DEC + k0 * 4) = (f32x2){__expf(tot0), __expf(tot1)};
        }
        __syncthreads();
        u32x4 rgy0, rgy1, rgp0, rgp1;
        if (rgdo) { const size_t r = rg_row0 + 16 * c + (lane >> 2); const int c0 = 8 * (lane & 3);
            const bf16_t* yp = (const bf16_t*)(a.ws + WS_Y) + r * D_ + 64 * rg_g + c0; const bf16_t* pq = (const bf16_t*)(a.ws + WS_PG) + r * 512 + 64 * rg_g + c0;
            rgy0 = *(const u32x4*)yp; rgy1 = *(const u32x4*)(yp + 32); rgp0 = __builtin_nontemporal_load((const u32x4*)pq); rgp1 = __builtin_nontemporal_load((const u32x4*)(pq + 32)); }
        f32x16 o;
        const int vt = w >> 1, tt = w & 1;
        if (PASS2) {
            { const int ti = w >> 1;
#pragma unroll
              for (int jj = 0; jj < 2; ++jj) { const int tj = 2 * (w & 1) + jj; f32x4 sc = (f32x4){0.f, 0.f, 0.f, 0.f};
                if (tj <= ti) {
#pragma unroll
                    for (int st = 0; st < 4; ++st) { const bf16x8 fa = *(const LAS bf16x8*)(lds + HG_QE + (16 * ti + l15) * 272 + (32 * st + 8 * q4) * 2);
                        const bf16x8 fb = *(const LAS bf16x8*)(lds + HG_KE + (16 * tj + l15) * 272 + (32 * st + 8 * q4) * 2); sc = MFMA16(fa, fb, sc); } }
                const int s = 16 * tj + l15;
#pragma unroll
                for (int r = 0; r < 4; ++r) { const int t = 16 * ti + 4 * q4 + r; const float v = (tj <= ti && s <= t) ? sc[r] : 0.f;
                    *(LAS bf16_t*)(lds + HG_P + t * 144 + s * 2) = f2bf(v); } }
            }
            __syncthreads();
            f32x16 o2;
#pragma unroll
            for (int r = 0; r < 16; ++r) { o[r] = 0.f; o2[r] = 0.f; }
#pragma unroll
            for (int st = 0; st < 8; ++st) { const bf16x8 fa = *(const LAS bf16x8*)(lds + HG_SB + (32 * vt + l31) * 272 + (16 * st + 8 * hh) * 2);
                const bf16x8 fb = *(const LAS bf16x8*)(lds + HG_QE + (32 * tt + l31) * 272 + (16 * st + 8 * hh) * 2); if (st & 1) o2 = MFMA32(fa, fb, o2); else o = MFMA32(fa, fb, o); }
#pragma unroll
            for (int st = 0; st < 4; ++st) { const bf16x8 fa = *(const LAS bf16x8*)(lds + HG_VT + (32 * vt + l31) * 144 + (16 * st + 8 * hh) * 2);
                const bf16x8 fb = *(const LAS bf16x8*)(lds + HG_P + (32 * tt + l31) * 144 + (16 * st + 8 * hh) * 2); if (st & 1) o2 = MFMA32(fa, fb, o2); else o = MFMA32(fa, fb, o); }
            float ss = 0.f;
#pragma unroll
            for (int r = 0; r < 16; ++r) { o[r] += o2[r]; ss += o[r] * o[r]; }
            ss += __shfl_xor(ss, 32);
            if (hh == 0) *(LAS float*)(lds + HG_PART + (vt * 64 + 32 * tt + l31) * 4) = ss;
            { const int t = 32 * tt + l31;
#pragma unroll
              for (int g = 0; g < 4; ++g) { const int v0 = 32 * vt + 8 * g + 4 * hh; u32x2 ow; ow.x = pk_bf16(o[4 * g], o[4 * g + 1]); ow.y = pk_bf16(o[4 * g + 2], o[4 * g + 3]);
                  *(LAS u32x2*)(lds + HG_OB + t * 272 + v0 * 2) = ow; } }
        }
#pragma unroll
        for (int g = 0; g < 4; ++g) { const f32x4 d = *(const LAS f32x4*)(lds + HG_DEC + (32 * kt + 8 * g + 4 * hh) * 4);
#pragma unroll
            for (int i = 0; i < 2; ++i)
#pragma unroll
                for (int j = 0; j < 4; ++j) S[i][4 * g + j] *= d[j]; }
#pragma unroll
        for (int st = 0; st < 4; ++st) { const bf16x8 fa = *(const LAS bf16x8*)(lds + HG_KDT + (32 * kt + l31) * 144 + (16 * st + 8 * hh) * 2);
#pragma unroll
            for (int i = 0; i < 2; ++i) { const bf16x8 fb = *(const LAS bf16x8*)(lds + HG_VT + (32 * ((w & 1) * 2 + i) + l31) * 144 + (16 * st + 8 * hh) * 2); S[i] = MFMA32(fa, fb, S[i]); } }
        if (PASS2) {
            __syncthreads();
            { const int t = tid >> 3, v0 = 8 * (tid & 7);
              const float tot = (*(const LAS float*)(lds + HG_PART + t * 4) + *(const LAS float*)(lds + HG_PART + (64 + t) * 4)) + (*(const LAS float*)(lds + HG_PART + (128 + t) * 4) + *(const LAS float*)(lds + HG_PART + (192 + t) * 4));
              const float rstd = rsqrtf(tot * (1.0f / 128.0f) + EPS_);
              const u32x4 ga = gpa, gb = gpb;
              const u32x4 oa = *(const LAS u32x4*)(lds + HG_OB + t * 272 + v0 * 2), ob = *(const LAS u32x4*)(lds + HG_OB + t * 272 + (64 + v0) * 2);
              u32x4 ya, yb;
#pragma unroll
              for (int j = 0; j < 4; ++j) { float g0 = bf_lo(ga[j]), g1 = bf_hi(ga[j]); ya[j] = pk_bf16(bf_lo(oa[j]) * rstd * nwv[j >> 1][2 * (j & 1)] * g0 * sigmoidf_(g0), bf_hi(oa[j]) * rstd * nwv[j >> 1][2 * (j & 1) + 1] * g1 * sigmoidf_(g1));
                  g0 = bf_lo(gb[j]); g1 = bf_hi(gb[j]); yb[j] = pk_bf16(bf_lo(ob[j]) * rstd * nwv[2 + (j >> 1)][2 * (j & 1)] * g0 * sigmoidf_(g0), bf_hi(ob[j]) * rstd * nwv[2 + (j >> 1)][2 * (j & 1) + 1] * g1 * sigmoidf_(g1)); }
              bf16_t* yp = (bf16_t*)(a.ws + WS_Y) + (rb + t) * D_ + 512 + 128 * h + v0;
              *(u32x4*)yp = ya; *(u32x4*)(yp + 64) = yb; }
            if (rgdo) { const size_t r = rg_row0 + 16 * c + (lane >> 2); const int c0 = 8 * (lane & 3);
                bf16_t* yp = (bf16_t*)(a.ws + WS_Y) + r * D_ + 64 * rg_g + c0; u32x4 o0, o1;
                const LAS float* Xc = (const LAS float*)(lds + 139264 + w * 256); f32x4 rgc[4];
#pragma unroll
                for (int k = 0; k < 4; ++k) rgc[k] = *(const LAS f32x4*)(Xc + c0 + 32 * (k >> 1) + 4 * (k & 1));
#pragma unroll
                for (int j = 0; j < 4; ++j) { const f32x4 ca = rgc[j >> 1], cb2 = rgc[2 + (j >> 1)];
                    o0[j] = pk_bf16(bf_lo(rgy0[j]) + bf_lo(rgp0[j]) * ca[2 * (j & 1)], bf_hi(rgy0[j]) + bf_hi(rgp0[j]) * ca[2 * (j & 1) + 1]);
                    o1[j] = pk_bf16(bf_lo(rgy1[j]) + bf_lo(rgp1[j]) * cb2[2 * (j & 1)], bf_hi(rgy1[j]) + bf_hi(rgp1[j]) * cb2[2 * (j & 1) + 1]); }
                *(u32x4*)yp = o0; *(u32x4*)(yp + 32) = o1; }
        }
    }
    if (!PASS2) {
        float* E = sseg + (size_t)item * 16384 + (size_t)w * 2048 + lane;
#pragma unroll
        for (int i = 0; i < 2; ++i)
#pragma unroll
            for (int r = 0; r < 16; ++r) E[(i * 16 + r) * 64] = S[i][r];
        if (w == 0) *(f32x2*)(dseg + item * 128 + k0) = (f32x2){__expf(segtot0), __expf(segtot1)};
    }
    __syncthreads();
}


constexpr int H1_KDT = 0, H1_VT = 67584, H1_TOT = 135168, H1_SC = 139264, H1_DEC = 143360;
DI void hgrn_pass1(const Args& a, LAS unsigned char* lds, int b, int h, int seg) {
    const int tid = threadIdx.x, lane = tid & 63, w = __builtin_amdgcn_readfirstlane(tid >> 6);
    const int l31 = lane & 31, hh = lane >> 5;
    const bf16_t* proj = (const bf16_t*)(a.ws + WS_PROJ);
    const int item = (b * 4 + h) * NSEG + seg;
    const int k0 = 2 * lane;
    const float* hglb = a.in[11];
    const float lb0 = rcpf_(1.0f + __expf(hglb[512 + 128 * h + k0] - hglb[128 * h + k0]));
    const float lb1 = rcpf_(1.0f + __expf(hglb[512 + 128 * h + k0 + 1] - hglb[128 * h + k0 + 1]));
    const float om0 = 1.0f - lb0, om1 = 1.0f - lb1;
    const int kt = w >> 1;
    f32x16 S[2];
#pragma unroll
    for (int i = 0; i < 2; ++i)
#pragma unroll
        for (int r = 0; r < 16; ++r) S[i][r] = 0.f;
    float segtot0 = 0.f, segtot1 = 0.f;
    const size_t row0 = (size_t)b * T_ + (size_t)seg * SEGLEN;
    for (int half = 0; half < 2; ++half) {
        const size_t rb = row0 + 256 * half + 32 * w;
        float cum0 = 0.f, cum1 = 0.f;
#pragma unroll
        for (int j = 0; j < 4; ++j) {
            unsigned fzw[8], vw[8];
#pragma unroll
            for (int q = 0; q < 8; ++q) { const size_t rr = rb + 8 * j + q; fzw[q] = *(const unsigned*)(proj + pidx(rr, COL_FB + 128 * h) + k0); vw[q] = *(const unsigned*)(proj + pidx(rr, COL_IB + 128 * h) + k0); }
            float c0[8], c1[8];
#pragma unroll
            for (int q = 0; q < 8; ++q) {
                const float z0 = bf_lo(fzw[q]), z1 = bf_hi(fzw[q]);
                const float e0 = __expf(-z0), e1 = __expf(-z1);
                const float s0 = rcpf_(1.0f + e0), s1 = rcpf_(1.0f + e1);
                cum0 += __logf(lb0 + om0 * s0); cum1 += __logf(lb1 + om1 * s1);
                c0[q] = om0 * e0 * s0 * __expf(-cum0); c1[q] = om1 * e1 * s1 * __expf(-cum1); }
            u32x4 o0, o1, p0, p1;
#pragma unroll
            for (int q = 0; q < 4; ++q) { o0[q] = pk_bf16(c0[2 * q], c0[2 * q + 1]); o1[q] = pk_bf16(c1[2 * q], c1[2 * q + 1]);
                p0[q] = (vw[2 * q] & 0xffffu) | (vw[2 * q + 1] << 16); p1[q] = (vw[2 * q] >> 16) | (vw[2 * q + 1] & 0xffff0000u); }
            *(LAS u32x4*)(lds + H1_KDT + k0 * 528 + (32 * w + 8 * j) * 2) = o0; *(LAS u32x4*)(lds + H1_KDT + (k0 + 1) * 528 + (32 * w + 8 * j) * 2) = o1;
            *(LAS u32x4*)(lds + H1_VT + k0 * 528 + (32 * w + 8 * j) * 2) = p0; *(LAS u32x4*)(lds + H1_VT + (k0 + 1) * 528 + (32 * w + 8 * j) * 2) = p1;
        }
        *(LAS f32x2*)(lds + H1_TOT + (w * 128 + k0) * 4) = (f32x2){cum0, cum1};
        __syncthreads();
        {
            float suf0 = 0.f, suf1 = 0.f, tot0 = 0.f, tot1 = 0.f;
#pragma unroll
            for (int g = 0; g < 8; ++g) { const f32x2 t = *(const LAS f32x2*)(lds + H1_TOT + (g * 128 + k0) * 4); if (g >= w) { suf0 += t.x; suf1 += t.y; } tot0 += t.x; tot1 += t.y; }
            *(LAS f32x2*)(lds + H1_SC + (w * 128 + k0) * 4) = (f32x2){__expf(suf0), __expf(suf1)};
            segtot0 += tot0; segtot1 += tot1;
            if (w == 0) *(LAS f32x2*)(lds + H1_DEC + k0 * 4) = (f32x2){__expf(tot0), __expf(tot1)};
        }
        __syncthreads();
        if (half) {
#pragma unroll
            for (int q = 0; q < 4; ++q) { const f32x4 d = *(const LAS f32x4*)(lds + H1_DEC + (32 * kt + 8 * q + 4 * hh) * 4);
#pragma unroll
                for (int i = 0; i < 2; ++i)
#pragma unroll
                    for (int j = 0; j < 4; ++j) S[i][4 * q + j] *= d[j]; } }
#pragma unroll 2
        for (int g = 0; g < 8; ++g) {
            f32x16 part[2];
#pragma unroll
            for (int i = 0; i < 2; ++i)
#pragma unroll
                for (int r = 0; r < 16; ++r) part[i][r] = 0.f;
#pragma unroll
            for (int st = 0; st < 2; ++st) { const bf16x8 fa = *(const LAS bf16x8*)(lds + H1_KDT + (32 * kt + l31) * 528 + (32 * g + 16 * st + 8 * hh) * 2);
#pragma unroll
                for (int i = 0; i < 2; ++i) { const bf16x8 fb = *(const LAS bf16x8*)(lds + H1_VT + (32 * ((w & 1) * 2 + i) + l31) * 528 + (32 * g + 16 * st + 8 * hh) * 2); part[i] = MFMA32(fa, fb, part[i]); } }
#pragma unroll
            for (int q = 0; q < 4; ++q) { const f32x4 sv = *(const LAS f32x4*)(lds + H1_SC + (g * 128 + 32 * kt + 8 * q + 4 * hh) * 4);
#pragma unroll
                for (int i = 0; i < 2; ++i)
#pragma unroll
                    for (int j = 0; j < 4; ++j) S[i][4 * q + j] += sv[j] * part[i][4 * q + j]; }
        }
        __syncthreads();
    }
    float* E = (float*)(a.ws + WS_SSEG) + (size_t)item * 16384 + (size_t)w * 2048 + lane;
#pragma unroll
    for (int i = 0; i < 2; ++i)
#pragma unroll
        for (int r = 0; r < 16; ++r) E[(i * 16 + r) * 64] = S[i][r];
    if (w == 0) *(f32x2*)((float*)(a.ws + WS_DSEG) + item * 128 + k0) = (f32x2){__expf(segtot0), __expf(segtot1)};
}

constexpr int RG_WAVE_LDS = 4352;

DI void rg_pass1(const Args& a, LAS unsigned char* lds, int sid) {
    const int lane = threadIdx.x & 63, w = __builtin_amdgcn_readfirstlane((int)(threadIdx.x >> 6));
    const int l15 = lane & 15, q4 = lane >> 4;
    const int b = sid >> 8, g = (sid >> 5) & 7, sseg = sid & 31;
    LAS float* const X0 = (LAS float*)(lds + w * 4 * RG_WAVE_LDS);
    const bf16_t* proj = (const bf16_t*)(a.ws + WS_PROJ);
    const int chl = 64 * g + lane;
    const float cw0 = a.in[4][chl], cw1 = a.in[4][512 + chl], cw2 = a.in[4][1024 + chl], cw3 = a.in[4][1536 + chl], cb = a.in[5][chl];
    bf16x8 BwA[4][2], BwX[4][2]; float cba[4], cbx[4], ccr[4];
    const bf16_t* wrg = (const bf16_t*)(a.ws + WS_WRG);
#pragma unroll
    for (int tj = 0; tj < 4; ++tj) { const int j = 16 * tj + l15;
#pragma unroll
        for (int st = 0; st < 2; ++st) { BwA[tj][st] = *(const bf16x8*)(wrg + ((size_t)(0 * 8 + g) * 64 + j) * 64 + 32 * st + 8 * q4); BwX[tj][st] = *(const bf16x8*)(wrg + ((size_t)(1 * 8 + g) * 64 + j) * 64 + 32 * st + 8 * q4); }
        cba[tj] = a.in[7][64 * g + j] * (-1.44269504f); cbx[tj] = a.in[9][64 * g + j] * (-1.44269504f);
        const float lam = a.in[10][64 * g + j];
        const float sp = (lam < -15.f) ? -lam : log1pf(__expf(-lam));
        ccr[tj] = -8.0f * sp; }
    f32x2* rgagg = (f32x2*)(a.ws + WS_RGAGG);
    float hc[4], prun[4];
#pragma unroll
    for (int tj = 0; tj < 4; ++tj) { hc[tj] = 0.f; prun[tj] = 1.f; }
    const size_t row0 = (size_t)b * T_ + (size_t)sseg * RG_SEGLEN;
    float h1 = 0.f, h2 = 0.f, h3 = 0.f;
    if (sseg > 0) { h3 = bf1(proj[pidx(row0 - 3, COL_XA + 64 * g) + lane]); h2 = bf1(proj[pidx(row0 - 2, COL_XA + 64 * g) + lane]); h1 = bf1(proj[pidx(row0 - 1, COL_XA + 64 * g) + lane]); }
    bf16_t xn[16];
#pragma unroll
    for (int i = 0; i < 16; ++i) xn[i] = proj[pidx(row0 + i, COL_XA + 64 * g) + lane];
#pragma unroll 2
    for (int tl = 0; tl < 8; ++tl) {
        const size_t rb = row0 + 16 * tl;
        LAS float* const X = X0 + (tl & 1) * (RG_WAVE_LDS / 4);
        LAS float* const XP = X0 + (2 + (tl & 1)) * (RG_WAVE_LDS / 4);
        float xa[16];
#pragma unroll
        for (int i = 0; i < 16; ++i) xa[i] = bf1(xn[i]);
        if (tl < 7) {
#pragma unroll
            for (int i = 0; i < 16; ++i) xn[i] = proj[pidx(rb + 16 + i, COL_XA + 64 * g) + lane]; }
        f32x4 pcv0, pcv1;
        { const f32x4* p4 = (const f32x4*)a.in[1] + (size_t)sid * 1024 + tl * 128 + lane; pcv0 = __builtin_nontemporal_load(p4); pcv1 = __builtin_nontemporal_load(p4 + 64); }
        u32x4 gw0, gw1;
        { const bf16_t* gp = proj + pidx(rb + (lane >> 2), COL_GA + 64 * g) + 8 * (lane & 3); gw0 = *(const u32x4*)gp; gw1 = *(const u32x4*)(gp + 32); }
#pragma unroll
        for (int i = 0; i < 16; ++i) { const float x3 = (i >= 3) ? xa[i - 3] : (i == 2 ? h1 : (i == 1 ? h2 : h3)), x2 = (i >= 2) ? xa[i - 2] : (i == 1 ? h1 : h2), x1 = (i >= 1) ? xa[i - 1] : h1;
            X[i * 68 + lane] = cb + (cw0 * x3 + cw1 * x2) + (cw2 * x1 + cw3 * xa[i]); }
        h3 = xa[13]; h2 = xa[14]; h1 = xa[15];
        bf16x8 fa[2];
#pragma unroll
        for (int st = 0; st < 2; ++st) { const f32x4 lo = *(const LAS f32x4*)(X + l15 * 68 + 32 * st + 8 * q4), hi = *(const LAS f32x4*)(X + l15 * 68 + 32 * st + 8 * q4 + 4);
            u32x4 p; p.x = pk_bf16(lo[0], lo[1]); p.y = pk_bf16(lo[2], lo[3]); p.z = pk_bf16(hi[0], hi[1]); p.w = pk_bf16(hi[2], hi[3]); fa[st] = __builtin_bit_cast(bf16x8, p); }
        float hl[4][4], pc[4][4], pinc[4], hinc[4];
#pragma unroll
        for (int tj = 0; tj < 4; ++tj) {
            f32x4 ar = (f32x4){0.f, 0.f, 0.f, 0.f}, ax = (f32x4){0.f, 0.f, 0.f, 0.f};
            ar = MFMA16(fa[0], BwA[tj][0], ar); ar = MFMA16(fa[1], BwA[tj][1], ar); ax = MFMA16(fa[0], BwX[tj][0], ax); ax = MFMA16(fa[1], BwX[tj][1], ax);
            float hh = 0.f, pp = 1.f;
#pragma unroll
            for (int r = 0; r < 4; ++r) { const int t = 4 * q4 + r;
                const float rr = rcpf_(1.0f + __builtin_amdgcn_exp2f(ar[r] + cba[tj])), ii = rcpf_(1.0f + __builtin_amdgcn_exp2f(ax[r] + cbx[tj]));
                const float la = ccr[tj] * rr; const float av = __expf(la);
                const float x2 = 2.0f * la;
                const float emp = x2 * (1.0f + x2 * 0.5f * (1.0f + x2 * (1.0f / 3.0f) * (1.0f + x2 * 0.25f * (1.0f + x2 * 0.2f * (1.0f + x2 * (1.0f / 6.0f))))));
                float eme = av * av - 1.0f;
                asm volatile("" : "+v"(eme));
                const float em = (x2 > -0.35f) ? emp : eme;
                float mult = __builtin_amdgcn_sqrtf(-em);
                if (sseg == 0 && tl == 0 && t == 0) mult = 1.0f;
                const float uv = mult * ii * X[t * 68 + 16 * tj + l15];
                hh = av * hh + uv; pp *= av; hl[tj][r] = hh; pc[tj][r] = pp; }
            float pu = __shfl_up(pp, 16), hu = __shfl_up(hh, 16);
            if (q4 >= 1) { hh = pp * hu + hh; pp = pp * pu; }
            pu = __shfl_up(pp, 32); hu = __shfl_up(hh, 32);
            if (q4 >= 2) { hh = pp * hu + hh; pp = pp * pu; }
            pinc[tj] = pp; hinc[tj] = hh;
        }
#pragma unroll
        for (int tj = 0; tj < 4; ++tj) { float pe = __shfl_up(pinc[tj], 16), he = __shfl_up(hinc[tj], 16); if (q4 == 0) { pe = 1.f; he = 0.f; }
            const float hin = pe * hc[tj] + he, pin = pe * prun[tj];
#pragma unroll
            for (int r = 0; r < 4; ++r) { X[(4 * q4 + r) * 68 + 16 * tj + l15] = hl[tj][r] + pc[tj][r] * hin; XP[(4 * q4 + r) * 68 + 16 * tj + l15] = pc[tj][r] * pin; } }
#pragma unroll
        for (int tj = 0; tj < 4; ++tj) { const float pt = __shfl(pinc[tj], 48 + l15), ht = __shfl(hinc[tj], 48 + l15); hc[tj] = pt * hc[tj] + ht; prun[tj] *= pt; }
        {
            const int t = lane >> 2, c0 = 8 * (lane & 3);
            f32x4 hv[4], pv[4];
#pragma unroll
            for (int k = 0; k < 4; ++k) { hv[k] = *(const LAS f32x4*)(X + t * 68 + c0 + 32 * (k >> 1) + 4 * (k & 1)); pv[k] = *(const LAS f32x4*)(XP + t * 68 + c0 + 32 * (k >> 1) + 4 * (k & 1)); }
            u32x4 y0, y1, p0, p1;
#pragma unroll
            for (int k = 0; k < 2; ++k) {
                float g0 = bf_lo(gw0[2 * k]), g1 = bf_hi(gw0[2 * k]), g2 = bf_lo(gw0[2 * k + 1]), g3 = bf_hi(gw0[2 * k + 1]);
                g0 *= sigmoidf_(g0); g1 *= sigmoidf_(g1); g2 *= sigmoidf_(g2); g3 *= sigmoidf_(g3);
                y0[2 * k] = pk_bf16(hv[k][0] * g0, hv[k][1] * g1); y0[2 * k + 1] = pk_bf16(hv[k][2] * g2, hv[k][3] * g3);
                p0[2 * k] = pk_bf16(pv[k][0] * g0, pv[k][1] * g1); p0[2 * k + 1] = pk_bf16(pv[k][2] * g2, pv[k][3] * g3);
                g0 = bf_lo(gw1[2 * k]); g1 = bf_hi(gw1[2 * k]); g2 = bf_lo(gw1[2 * k + 1]); g3 = bf_hi(gw1[2 * k + 1]);
                g0 *= sigmoidf_(g0); g1 *= sigmoidf_(g1); g2 *= sigmoidf_(g2); g3 *= sigmoidf_(g3);
                y1[2 * k] = pk_bf16(hv[2 + k][0] * g0, hv[2 + k][1] * g1); y1[2 * k + 1] = pk_bf16(hv[2 + k][2] * g2, hv[2 + k][3] * g3);
                p1[2 * k] = pk_bf16(pv[2 + k][0] * g0, pv[2 + k][1] * g1); p1[2 * k + 1] = pk_bf16(pv[2 + k][2] * g2, pv[2 + k][3] * g3); }
            bf16_t* yp = (bf16_t*)(a.ws + WS_Y) + (rb + t) * D_ + 64 * g + c0;
            *(u32x4*)yp = y0; *(u32x4*)(yp + 32) = y1;
            bf16_t* pq = (bf16_t*)(a.ws + WS_PG) + (rb + t) * 512 + 64 * g + c0;
            *(u32x4*)pq = p0; *(u32x4*)(pq + 32) = p1;
            { u32x2* pb = (u32x2*)(a.ws + WS_PB) + (size_t)sid * 1024 + tl * 128 + lane; u32x2 o; o.x = pk_bf16(pcv0[0], pcv0[1]); o.y = pk_bf16(pcv0[2], pcv0[3]); pb[0] = o; o.x = pk_bf16(pcv1[0], pcv1[1]); o.y = pk_bf16(pcv1[2], pcv1[3]); pb[64] = o; }
        }
    }
    if (q4 == 0) {
#pragma unroll
        for (int tj = 0; tj < 4; ++tj) rgagg[(size_t)(b * RG_NSEG + sseg) * 512 + 64 * g + 16 * tj + l15] = (f32x2){prun[tj], hc[tj]}; }
}

DI void rg_pass2(const Args& a, LAS unsigned char* lds, int sid) {
    const int lane = threadIdx.x & 63, w = __builtin_amdgcn_readfirstlane((int)(threadIdx.x >> 6));
    const int l15 = lane & 15, q4 = lane >> 4;
    const int b = sid >> 8, g = (sid >> 5) & 7, sseg = sid & 31;
    if (sseg == 0) return;
    LAS float* const X = (LAS float*)(lds + w * 4 * RG_WAVE_LDS);
    const f32x2* rgagg = (const f32x2*)(a.ws + WS_RGAGG);
    float hc[4];
#pragma unroll
    for (int tj = 0; tj < 4; ++tj) hc[tj] = 0.f;
    for (int sp0 = 0; sp0 < sseg; sp0 += 8) {
        f32x2 ag[8][4];
#pragma unroll
        for (int k = 0; k < 8; ++k)
#pragma unroll
            for (int tj = 0; tj < 4; ++tj) { const int sp = (sp0 + k < sseg) ? sp0 + k : sseg - 1; ag[k][tj] = rgagg[(size_t)(b * RG_NSEG + sp) * 512 + 64 * g + 16 * tj + l15]; }
#pragma unroll
        for (int k = 0; k < 8; ++k) { if (sp0 + k < sseg) {
#pragma unroll
                for (int tj = 0; tj < 4; ++tj) hc[tj] = ag[k][tj].x * hc[tj] + ag[k][tj].y; } }
    }
    if (q4 == 0) {
#pragma unroll
        for (int tj = 0; tj < 4; ++tj) X[16 * tj + l15] = hc[tj]; }
    const int t = lane >> 2, c0 = 8 * (lane & 3);
    f32x4 cv[4];
#pragma unroll
    for (int k = 0; k < 4; ++k) cv[k] = *(const LAS f32x4*)(X + c0 + 32 * (k >> 1) + 4 * (k & 1));
    const size_t row0 = (size_t)b * T_ + (size_t)sseg * RG_SEGLEN;
#pragma unroll 2
    for (int t4 = 0; t4 < 2; ++t4) {
        u32x4 yv[4][2], pv[4][2];
#pragma unroll
        for (int q = 0; q < 4; ++q) { const size_t r = row0 + 16 * (4 * t4 + q) + t;
            const bf16_t* yp = (const bf16_t*)(a.ws + WS_Y) + r * D_ + 64 * g + c0; const bf16_t* pq = (const bf16_t*)(a.ws + WS_PG) + r * 512 + 64 * g + c0;
            yv[q][0] = *(const u32x4*)yp; yv[q][1] = *(const u32x4*)(yp + 32); pv[q][0] = __builtin_nontemporal_load((const u32x4*)pq); pv[q][1] = __builtin_nontemporal_load((const u32x4*)(pq + 32)); }
#pragma unroll
        for (int q = 0; q < 4; ++q) { const size_t r = row0 + 16 * (4 * t4 + q) + t; bf16_t* yp = (bf16_t*)(a.ws + WS_Y) + r * D_ + 64 * g + c0;
#pragma unroll
            for (int hf = 0; hf < 2; ++hf) { u32x4 o;
#pragma unroll
                for (int j = 0; j < 4; ++j) { const f32x4 c = cv[2 * hf + (j >> 1)];
                    o[j] = pk_bf16(bf_lo(yv[q][hf][j]) + bf_lo(pv[q][hf][j]) * c[2 * (j & 1)], bf_hi(yv[q][hf][j]) + bf_hi(pv[q][hf][j]) * c[2 * (j & 1) + 1]); }
                *(u32x4*)(yp + 32 * hf) = o; } }
    }
}

#define XB_TMO      128
#define XB_XCNT(j)  (256  + 64 * (j))
#define XB_XSUB(j)  (1280 + 64 * (j))
#define XB_XGEN(j)  (2304 + 64 * (j))
#define XB_TOP      3328
#define XB_TOPGEN   3392
#define XCD_BAR_WORDS 3456
#define XB_SPIN_CAP (1u << 18)
DI unsigned xb_ld(unsigned* p)              { return __hip_atomic_load(p, __ATOMIC_RELAXED, __HIP_MEMORY_SCOPE_AGENT); }
DI unsigned xb_add(unsigned* p, unsigned v) { return __hip_atomic_fetch_add(p, v, __ATOMIC_RELAXED, __HIP_MEMORY_SCOPE_AGENT); }
DI unsigned xb_xcc_id() { return (unsigned)__builtin_amdgcn_s_getreg((3 << 11) | 20) & 0xFu; }
#define XB_SPIN(cond, bar) do { unsigned _sp = 0; while (cond) { __builtin_amdgcn_s_sleep(1); \
    if ((++_sp & 255u) == 0u) { if (xb_ld(&(bar)[XB_TMO])) break; if (_sp > XB_SPIN_CAP) { atomicAdd(&(bar)[XB_TMO], 1u); break; } } } } while (0)
struct XcdBarrier { unsigned* bar; unsigned x; volatile LAS unsigned* st; };
DI XcdBarrier xcd_barrier_post(unsigned* bar, volatile LAS unsigned* st) {
    XcdBarrier b; b.bar = bar; b.x = xb_xcc_id(); b.st = st;
    if (threadIdx.x == 0) (void)xb_add(&bar[XB_XCNT(b.x)], 1u);
    return b;
}
DI void xcd_barrier_complete(unsigned* bar, unsigned x, unsigned& nloc, unsigned& nx) {
    const unsigned G = gridDim.x * gridDim.y * gridDim.z;
    unsigned sum, cnt, mine, sp = 0u;
    for (;;) {
        sum = 0u; cnt = 0u; mine = 0u;
#pragma unroll
        for (unsigned j = 0; j < 16; ++j) { const unsigned c = xb_ld(&bar[XB_XCNT(j)]); sum += c; cnt += (c > 0u) ? 1u : 0u; mine = (j == x) ? c : mine; }
        if (sum == G) break;
        __builtin_amdgcn_s_sleep(1);
        if ((++sp & 255u) == 0u) { if (xb_ld(&bar[XB_TMO])) break; if (sp > XB_SPIN_CAP) { atomicAdd(&bar[XB_TMO], 1u); break; } }
    }
    nloc = mine > 0u ? mine : 1u; nx = cnt > 0u ? cnt : 1u;
}
DI void xcd_barrier(const XcdBarrier& b) {
    asm volatile("s_waitcnt vmcnt(0)" ::: "memory");
    __syncthreads();
    if (threadIdx.x == 0) {
        unsigned* bar = b.bar;
        __builtin_amdgcn_s_waitcnt(0);
        unsigned nloc = b.st[0], nx = b.st[1];
        if (nloc == 0u) { xcd_barrier_complete(bar, b.x, nloc, nx); b.st[0] = nloc; b.st[1] = nx; }
        const unsigned old = xb_add(&bar[XB_XSUB(b.x)], 1u);
        const unsigned gen = old / nloc;
        if (old + 1u == (gen + 1u) * nloc) {
            __builtin_amdgcn_fence(__ATOMIC_RELEASE, "agent");
            asm volatile("s_waitcnt vmcnt(0)" ::: "memory");
            const unsigned og = xb_add(&bar[XB_TOP], 1u);
            const unsigned tg = og / nx;
            if (og + 1u == (tg + 1u) * nx) xb_add(&bar[XB_TOPGEN], 1u);
            else XB_SPIN(xb_ld(&bar[XB_TOPGEN]) == tg, bar);
            __builtin_amdgcn_fence(__ATOMIC_ACQUIRE, "agent");
            xb_add(&bar[XB_XGEN(b.x)], 1u);
            asm volatile("s_waitcnt vmcnt(0)" ::: "memory");
        } else {
            XB_SPIN(xb_ld(&bar[XB_XGEN(b.x)]) == gen, bar);
            __builtin_amdgcn_fence(__ATOMIC_ACQUIRE, "agent");
            asm volatile("s_waitcnt vmcnt(0)" ::: "memory");
        }
    }
    __syncthreads();
}

__global__ void __launch_bounds__(512, 2) fwd_kernel(Args args) {
    extern __shared__ __attribute__((aligned(16))) unsigned char lds_raw[];
    LAS unsigned char* lds = (LAS unsigned char*)lds_raw;
    const int lo = args.ph_lo, hi = args.ph_hi;
    const int G = gridDim.x, bx = blockIdx.x;
#define IN(k) (lo <= (k) && (k) < hi)
    if (threadIdx.x < 4) *(LAS unsigned*)(lds + LDS_BARW + 4 * threadIdx.x) = 0u;
    __syncthreads();
    XcdBarrier bar; bar.bar = (unsigned*)(args.ws + WS_BAR); bar.x = 0; bar.st = nullptr;
    if (hi - lo > 1) bar = xcd_barrier_post((unsigned*)(args.ws + WS_BAR), (volatile LAS unsigned*)(lds + LDS_BARW));
    if (lo > hi) cg::this_grid().sync();
#define SEAM(k) do { if (IN(k) && IN((k) + 1)) { xcd_barrier(bar); } } while (0)
    if (IN(0)) { for (int rep = 0; rep < REP_P0; ++rep) p0_prologue(args, lds); for (int rep = 0; rep < REP_SYNC; ++rep) xcd_barrier(bar); }
    SEAM(0);
    if (IN(1)) {
        pg8::Gemm g{(const bf16_t*)(args.ws + WS_U), (const bf16_t*)(args.ws + WS_WIN), M_, DIN_, D_}; pg8::StaticOrder S; S.init(M_, DIN_, G, bx);
        pg8::EpiBf16<true> E{(bf16_t*)(args.ws + WS_PROJ), DIN_};
        for (int rep = 0; rep < REP_G1; ++rep) pg8::gemm_phase(lds, g, S, E);
    }
    SEAM(1);
    if (IN(2)) {
        for (int rep = 0; rep < REP_H; ++rep) for (int it = bx; it < 256; it += G) { const int seg = it & 7; if (seg < 7) hgrn_pass1(args, lds, it >> 5, (it >> 3) & 3, seg); }
        for (int sid = bx * 8 + (int)(threadIdx.x >> 6); sid < 2048; sid += G * 8) rg_pass1(args, lds, sid);
    }
    SEAM(2);
    if (IN(3)) {
        const bool fuse = (G == 256);
        for (int it = bx; it < 256; it += G) hgrn_item<true>(args, lds, it >> 5, (it >> 3) & 3, it & 7, fuse ? bx * 8 + (int)(threadIdx.x >> 6) : -1);
        if (!fuse) for (int sid = bx * 8 + (int)(threadIdx.x >> 6); sid < 2048; sid += G * 8) rg_pass2(args, lds, sid);
    }
    SEAM(3);
    if (IN(4)) {
        const bool pp_last = ((bx >> 3) & 1) != 0;
        if (!pp_last) { pg8::Gemm g{(const bf16_t*)(args.ws + WS_PB), (const bf16_t*)(args.ws + WS_WP), M_, D_, PLE_}; pg8::StaticOrder S; S.init(M_, D_, G, bx);
          pg8::EpiBf16<false> E{(bf16_t*)(args.ws + WS_PP), D_}; pg8::gemm_phase(lds, g, S, E); }
        { pg8::Gemm g{(const bf16_t*)(args.ws + WS_Y), (const bf16_t*)(args.ws + WS_WOUT), M_, D_, D_}; pg8::StaticOrder S; S.init(M_, D_, G, bx);
          pg8::EpiH E{(const bf16_t*)(args.ws + WS_U), (const float*)(args.ws + WS_RSX), (bf16_t*)(args.ws + WS_HB), (float*)(args.ws + WS_RSS1)}; pg8::gemm_phase(lds, g, S, E); }
        if (pp_last) { pg8::Gemm g{(const bf16_t*)(args.ws + WS_PB), (const bf16_t*)(args.ws + WS_WP), M_, D_, PLE_}; pg8::StaticOrder S; S.init(M_, D_, G, bx);
          pg8::EpiBf16<false> E{(bf16_t*)(args.ws + WS_PP), D_}; pg8::gemm_phase(lds, g, S, E); }
    }
    SEAM(4);
    if (IN(5)) {
        pg8::Gemm g{(const bf16_t*)(args.ws + WS_HB), (const bf16_t*)(args.ws + WS_WG), M_, D_, D_}; pg8::StaticOrder S; S.init(M_, D_, G, bx);
        pg8::EpiGate E{(bf16_t*)(args.ws + WS_Y), (const bf16_t*)(args.ws + WS_PP), args.in[16], (const float*)(args.ws + WS_RSS1)};
        pg8::gemm_phase(lds, g, S, E);
    }
    SEAM(5);
    if (IN(6)) {
        const u32x2* hb4 = (const u32x2*)(args.ws + WS_HB); const u32x2* gp4 = (const u32x2*)(args.ws + WS_Y); const f32x4* fw = (const f32x4*)args.in[18]; f32x4* o4 = (f32x4*)args.out;
        const int lane = threadIdx.x & 63, gw = bx * 8 + (int)(threadIdx.x >> 6), nw = G * 8;
        f32x4 wv[4];
#pragma unroll
        for (int sl = 0; sl < 4; ++sl) wv[sl] = fw[64 * sl + lane];
        for (int row = 4 * gw; row < M_; row += 4 * nw) {
            u32x2 hv[4][4], gv[4][4];
#pragma unroll
            for (int r = 0; r < 4; ++r)
#pragma unroll
                for (int sl = 0; sl < 4; ++sl) { const size_t i = (size_t)(row + r) * 256 + 64 * sl + lane; hv[r][sl] = __builtin_nontemporal_load(hb4 + i); gv[r][sl] = __builtin_nontemporal_load(gp4 + i); }
#pragma unroll
            for (int r = 0; r < 4; ++r) { f32x4 h2[4]; float ss = 0.f;
#pragma unroll
                for (int sl = 0; sl < 4; ++sl) { h2[sl] = (f32x4){bf_lo(hv[r][sl].x) + bf_lo(gv[r][sl].x), bf_hi(hv[r][sl].x) + bf_hi(gv[r][sl].x), bf_lo(hv[r][sl].y) + bf_lo(gv[r][sl].y), bf_hi(hv[r][sl].y) + bf_hi(gv[r][sl].y)};
                    ss += (h2[sl][0] * h2[sl][0] + h2[sl][1] * h2[sl][1]) + (h2[sl][2] * h2[sl][2] + h2[sl][3] * h2[sl][3]); }
#pragma unroll
                for (int o = 1; o < 64; o <<= 1) ss += __shfl_xor(ss, o);
                const float rstd = rsqrtf(ss * (1.0f / 1024.0f) + EPS_);
#pragma unroll
                for (int sl = 0; sl < 4; ++sl) __builtin_nontemporal_store(h2[sl] * rstd * wv[sl], o4 + (size_t)(row + r) * 256 + 64 * sl + lane); }
        }
    }
#undef IN
#undef SEAM
}

extern "C" void kernel_launch(void* const* d_in, const int* in_sizes, int n_in, void* d_out, int out_size, void* d_ws, size_t ws_size, hipStream_t stream) {
    static int grid = 0;
    if (grid == 0) {
        if (n_in != 19 || out_size != M_ * D_ || ws_size < WS_END) { fprintf(stderr, "kernel_launch: unexpected shapes (n_in %d out %d ws %zu need %zu)\n", n_in, out_size, ws_size, (size_t)WS_END); grid = -1; return; }
        int dev = 0, cus = 0, per_cu = 0;
        hipGetDevice(&dev); hipDeviceGetAttribute(&cus, hipDeviceAttributeMultiprocessorCount, dev);
        if (hipFuncSetAttribute((const void*)fwd_kernel, hipFuncAttributeMaxDynamicSharedMemorySize, LDS_BYTES) != hipSuccess) { fprintf(stderr, "kernel_launch: hipFuncSetAttribute failed\n"); grid = -1; return; }
        hipOccupancyMaxActiveBlocksPerMultiprocessor(&per_cu, (const void*)fwd_kernel, 512, LDS_BYTES);
        (void)hipGetLastError();
        if (per_cu < 1) per_cu = 1;
        grid = cus;
        fprintf(stderr, "kernel_launch: cus %d per_cu %d grid %d\n", cus, per_cu, grid);
    }
    if (grid < 0) return;
    Args a{};
    for (int i = 0; i < 19; ++i) a.in[i] = (const float*)d_in[i];
    a.out = (float*)d_out; a.ws = (unsigned char*)d_ws;
#if N_LAUNCHES == 1
    a.ph_lo = 0; a.ph_hi = 7;
    if (hipMemsetAsync((unsigned char*)d_ws + WS_BAR, 0, 16384, stream) != hipSuccess) { fprintf(stderr, "kernel_launch: memset of barrier words failed\n"); return; }
    void* kargs[] = {&a};
    hipError_t e = hipLaunchCooperativeKernel((const void*)fwd_kernel, dim3(grid), dim3(512), kargs, LDS_BYTES, stream);
    if (e != hipSuccess) fprintf(stderr, "cooperative launch failed: %s (grid %d)\n", hipGetErrorString(e), grid);
#else
    for (int ph = 0; ph < 7; ++ph) { a.ph_lo = ph; a.ph_hi = ph + 1; hipLaunchKernelGGL(fwd_kernel, dim3(grid), dim3(512), LDS_BYTES, stream, a); }
#endif
}
```
